# Optimizing an MI355X kernel written in HIP

```python
import jax
import jax.numpy as jnp
from jax import lax
import numpy as np


D_MODEL = 1024
BATCH = 4
SEQ = 4096
DEPTH = 2

CTX_LEN = 256
GRID_W = 64
EPS = 1e-6
MASK_VALUE = -1e30
LB_FLOOR = 1e-30
N_MOD = 6

ATT_W = D_MODEL // 2
HG_W = D_MODEL // 4
CV_W = D_MODEL - ATT_W - HG_W
MIX_W = ATT_W + HG_W + CV_W

HEAD_DIM = 64
N_Q = ATT_W // HEAD_DIM
N_KV = 2
GQA_GROUP = N_Q // N_KV
KV_W = N_KV * HEAD_DIM
WINDOW = 128
ATT_BLOCK = 128
ROPE_BASE = 10000.0
ROPE_FREQS = HEAD_DIM // 4

HG_DIM = 64
HG_HEADS = HG_W // HG_DIM
HG_CHUNK = 16

CONV_WIDTH = 3

N_EXPERTS = 16
EC_CAPACITY = 2
D_EXPERT = 2048

OFF_K = 0
OFF_V = OFF_K + KV_W
OFF_I = OFF_V + KV_W
OFF_FF = OFF_I + HG_W
OFF_FB = OFF_FF + HG_W
STATE_COLS = OFF_FB + HG_W
OFF_Q = STATE_COLS
OFF_HQ = OFF_Q + ATT_W
OFF_G = OFF_HQ + HG_W
OFF_CB = OFF_G + HG_W
OFF_CC = OFF_CB + CV_W
OFF_CH = OFF_CC + CV_W
IN_COLS = OFF_CH + CV_W

kernel_name = 'hybrid_hymba_dit_block'

F32 = jnp.float32


def rmsnorm(x, g):
    x32 = x.astype(F32)
    y = x32 * lax.rsqrt(jnp.mean(x32 * x32, axis=-1, keepdims=True) + EPS)
    return (y * g.astype(F32)).astype(x.dtype)


def modulate(h, shift, scale):
    return h * (1 + scale) + shift


def axial_rope_tables(n_rows, dtype):
    row = jnp.repeat(jnp.arange(n_rows), GRID_W)
    col = jnp.tile(jnp.arange(GRID_W), n_rows)
    pos = jnp.stack([row, col], axis=-1).astype(F32)
    inv = ROPE_BASE ** (-jnp.arange(ROPE_FREQS, dtype=F32) / ROPE_FREQS)
    ang = pos[:, :, None] * inv
    return jnp.cos(ang).astype(dtype), jnp.sin(ang).astype(dtype)


def apply_rope(x, cos, sin):
    B, T, H, _ = x.shape
    xr = x.reshape(B, T, H, 2, 2, ROPE_FREQS)
    x1, x2 = xr[..., 0, :], xr[..., 1, :]
    c, s = cos[None, :, None], sin[None, :, None]
    out = jnp.stack([x1 * c - x2 * s, x2 * c + x1 * s], axis=-2)
    return out.reshape(x.shape)


def window_attention(q, k, v, kc, vc, sink):
    B, T = q.shape[:2]
    L = kc.shape[1]
    nb = T // ATT_BLOCK
    scale = HEAD_DIM ** -0.5
    qb = q.reshape(B, nb, ATT_BLOCK, N_KV, GQA_GROUP, HEAD_DIM)

    def band_blocks(a):
        ap = jnp.pad(a, ((0, 0), (ATT_BLOCK, ATT_BLOCK), (0, 0), (0, 0)))
        ap = ap.reshape(B, nb + 2, ATT_BLOCK, N_KV, HEAD_DIM)
        return jnp.concatenate([ap[:, :-2], ap[:, 1:-1], ap[:, 2:]], axis=2)

    kw, vw = band_blocks(k), band_blocks(v)
    n_lat = 3 * ATT_BLOCK
    qi = jnp.arange(ATT_BLOCK)[:, None]
    kj = jnp.arange(n_lat)[None, :] - ATT_BLOCK
    band = jnp.abs(kj - qi) <= WINDOW
    abs_pos = jnp.arange(nb)[:, None] * ATT_BLOCK + kj
    valid = (abs_pos >= 0) & (abs_pos < T)
    mask = band[None] & valid[:, None, :]

    s_lat = jnp.einsum('bnqkgd,bnskd->bnkgqs', qb, kw).astype(F32) * scale
    s_lat = jnp.where(mask[None, :, None, None], s_lat, MASK_VALUE)
    s_ctx = jnp.einsum('bnqkgd,bmkd->bnkgqm', qb, kc).astype(F32) * scale
    s_sink = jnp.broadcast_to(sink.astype(F32).reshape(N_KV, GQA_GROUP, 1, 1), s_lat.shape[:-1] + (1,))
    p = jax.nn.softmax(jnp.concatenate([s_lat, s_ctx, s_sink], axis=-1), axis=-1).astype(v.dtype)
    out = (jnp.einsum('bnkgqs,bnskd->bnqkgd', p[..., :n_lat], vw)
           + jnp.einsum('bnkgqm,bmkd->bnqkgd', p[..., n_lat:n_lat + L], vc))
    return out.reshape(B, T, N_Q * HEAD_DIM)


def context_attention(qc, kc, vc, sink):
    B, L = qc.shape[:2]
    qg = qc.reshape(B, L, N_KV, GQA_GROUP, HEAD_DIM)
    s = jnp.einsum('blkgd,bmkd->bkglm', qg, kc).astype(F32) * HEAD_DIM ** -0.5
    s_sink = jnp.broadcast_to(sink.astype(F32).reshape(N_KV, GQA_GROUP, 1, 1), s.shape[:-1] + (1,))
    p = jax.nn.softmax(jnp.concatenate([s, s_sink], axis=-1), axis=-1)[..., :L].astype(vc.dtype)
    out = jnp.einsum('bkglm,bmkd->blkgd', p, vc)
    return out.reshape(B, L, N_Q * HEAD_DIM)


def hgrn_gates(z, lb):
    z32 = z.astype(F32)
    log_lb = jnp.log(jnp.maximum(lb, LB_FLOOR))
    log_f = jnp.logaddexp(log_lb, jnp.log1p(-lb) + jax.nn.log_sigmoid(z32))
    k = (1.0 - lb) * jax.nn.sigmoid(-z32)
    return log_f, k


def _chunk(a):
    return a.reshape(a.shape[0], a.shape[1] // HG_CHUNK, HG_CHUNK, *a.shape[2:])


def _chunk_summaries(k, v, log_f):
    lam = jnp.cumsum(log_f, axis=2)
    lam_last = lam[:, :, -1]
    k_dec = k * jnp.exp(lam_last[:, :, None] - lam)
    u = jnp.einsum('bnshd,bnshv->bnhdv', k_dec, v)
    return lam, jnp.exp(lam_last), u


def _scan_states(decay, u, s0):
    def step(s, xs):
        a, uu = xs
        return a[..., None] * s + uu, s
    s_fin, s_before = lax.scan(step, s0, (jnp.moveaxis(decay, 1, 0), jnp.moveaxis(u, 1, 0)))
    return s_before, s_fin


def gla_final_state(k, v, log_f, s0):
    k, v, log_f = (_chunk(a.astype(F32)) for a in (k, v, log_f))
    _, decay, u = _chunk_summaries(k, v, log_f)
    return _scan_states(decay, u, s0)[1]


def gla_chunkwise(q, k, v, log_f, s0):
    B, T, H, dv = v.shape
    dtype = v.dtype
    q, k, v, log_f = (_chunk(a.astype(F32)) for a in (q, k, v, log_f))
    lam, decay, u = _chunk_summaries(k, v, log_f)
    s_before, s_fin = _scan_states(decay, u, s0)
    causal = jnp.tril(jnp.ones((HG_CHUNK, HG_CHUNK), dtype=bool))[:, :, None, None]
    diff = lam[:, :, :, None] - lam[:, :, None, :]
    dec = jnp.where(causal, jnp.exp(jnp.where(causal, diff, 0.0)), 0.0)
    a = jnp.einsum('bnthd,bnshd,bntshd->bnhts', q, k, dec)
    o = (jnp.einsum('bnhts,bnshv->bnthv', a, v)
         + jnp.einsum('bnthd,nbhdv->bnthv', q * jnp.exp(lam), s_before))
    return o.reshape(B, T, H, dv).astype(dtype), s_fin


def hgrn_readout(o, g, gain):
    B, T = o.shape[:2]
    o32 = o.astype(F32)
    on = o32 * lax.rsqrt(jnp.mean(o32 * o32, axis=-1, keepdims=True) + EPS)
    on = on * gain.astype(F32).reshape(HG_HEADS, HG_DIM)
    return (on.reshape(B, T, HG_W) * jax.nn.silu(g.astype(F32))).astype(g.dtype)


def dwconv3(u, w):
    up = jnp.pad(u, ((0, 0), (1, 1), (0, 0)))
    return up[:, :-2] * w[0] + up[:, 1:-1] * w[1] + up[:, 2:] * w[2]


def token_mixers(hl, hc, w_in, w_o, sink, lb_f, lb_b, hg_gain, conv_w, cos, sin, need_ctx_out):
    pl = hl @ w_in
    pc = hc @ (w_in if need_ctx_out else w_in[:, :STATE_COLS])

    def col(p, off, width):
        return p[..., off:off + width]

    def heads(a, n_heads):
        return a.reshape(a.shape[0], a.shape[1], n_heads, -1)

    def flip(a):
        return jnp.flip(a, axis=1)

    ql = apply_rope(heads(col(pl, OFF_Q, ATT_W), N_Q), cos, sin)
    kl = apply_rope(heads(col(pl, OFF_K, KV_W), N_KV), cos, sin)
    vl = heads(col(pl, OFF_V, KV_W), N_KV)
    kc = heads(col(pc, OFF_K, KV_W), N_KV)
    vc = heads(col(pc, OFF_V, KV_W), N_KV)
    att_l = window_attention(ql, kl, vl, kc, vc, sink)

    def hg_inputs(p):
        i = heads(col(p, OFF_I, HG_W), HG_HEADS)
        lf_f, k_f = hgrn_gates(heads(col(p, OFF_FF, HG_W), HG_HEADS), lb_f)
        lf_b, k_b = hgrn_gates(heads(col(p, OFF_FB, HG_W), HG_HEADS), lb_b)
        return i, lf_f, k_f, lf_b, k_b

    i_c, lfc_f, kc_f, lfc_b, kc_b = hg_inputs(pc)
    i_l, lfl_f, kl_f, lfl_b, kl_b = hg_inputs(pl)
    s0 = jnp.zeros((hl.shape[0], HG_HEADS, HG_DIM, HG_DIM), F32)
    if need_ctx_out:
        qc_h = jax.nn.silu(heads(col(pc, OFF_HQ, HG_W), HG_HEADS))
        oc_f, sc_f = gla_chunkwise(qc_h, kc_f, i_c, lfc_f, s0)
        oc_b, sc_b = gla_chunkwise(flip(qc_h), flip(kc_b), flip(i_c), flip(lfc_b), s0)
    else:
        sc_f = gla_final_state(kc_f, i_c, lfc_f, s0)
        sc_b = gla_final_state(flip(kc_b), flip(i_c), flip(lfc_b), s0)
    ql_h = jax.nn.silu(heads(col(pl, OFF_HQ, HG_W), HG_HEADS))
    ol_f, _ = gla_chunkwise(ql_h, kl_f, i_l, lfl_f, sc_f)
    ol_b, _ = gla_chunkwise(flip(ql_h), flip(kl_b), flip(i_l), flip(lfl_b), sc_b)
    hg_l = hgrn_readout(ol_f + flip(ol_b), col(pl, OFF_G, HG_W), hg_gain)

    conv_l = col(pl, OFF_CB, CV_W) * dwconv3(col(pl, OFF_CC, CV_W) * col(pl, OFF_CH, CV_W), conv_w)

    mix_l = jnp.concatenate([att_l, hg_l, conv_l], axis=-1) @ w_o
    if not need_ctx_out:
        return mix_l, None

    att_c = context_attention(heads(col(pc, OFF_Q, ATT_W), N_Q), kc, vc, sink)
    hg_c = hgrn_readout(oc_f + flip(oc_b), col(pc, OFF_G, HG_W), hg_gain)
    conv_c = col(pc, OFF_CB, CV_W) * dwconv3(col(pc, OFF_CC, CV_W) * col(pc, OFF_CH, CV_W), conv_w)
    mix_c = jnp.concatenate([att_c, hg_c, conv_c], axis=-1) @ w_o
    return mix_l, mix_c


def expert_choice_moe(h, w_router, w_gate, w_up, w_down):
    B, N, D = h.shape
    cap = EC_CAPACITY * N // N_EXPERTS
    aff = jax.nn.softmax((h @ w_router).astype(F32), axis=-1)
    g, idx = lax.top_k(jnp.swapaxes(aff, 1, 2), cap)
    xs = jax.vmap(lambda hb, ib: hb[ib])(h, idx)
    hid = jax.nn.silu(jnp.einsum('becd,edf->becf', xs, w_gate)) * jnp.einsum('becd,edf->becf', xs, w_up)
    y = jnp.einsum('becf,efd->becd', hid, w_down) * g[..., None].astype(h.dtype)
    return jax.vmap(lambda ib, yb: jnp.zeros((N, D), yb.dtype).at[ib.reshape(-1)].add(yb.reshape(-1, D)))(idx, y)


def setup_inputs(seed: int = 0) -> dict:
    key = jax.random.key(seed)
    ks = jax.random.split(key, 20)

    def nrm(k, shape, s):
        return jax.random.normal(k, shape, F32) * s

    return {
        'x': nrm(ks[0], (BATCH, SEQ, D_MODEL), 1.0),
        'c': nrm(ks[1], (BATCH, D_MODEL), 1.0),
        'ctx': nrm(ks[2], (BATCH, CTX_LEN, D_MODEL), 1.0),
        'c_ctx': nrm(ks[3], (D_MODEL,), 1.0),
        'ada_w': nrm(ks[4], (DEPTH, D_MODEL, N_MOD * D_MODEL), D_MODEL ** -0.5),
        'ada_b': nrm(ks[5], (DEPTH, N_MOD * D_MODEL), 0.02),
        'norm1_g': 1.0 + nrm(ks[6], (DEPTH, D_MODEL), 0.1),
        'norm2_g': 1.0 + nrm(ks[7], (DEPTH, D_MODEL), 0.1),
        'w_in': nrm(ks[8], (DEPTH, D_MODEL, IN_COLS), D_MODEL ** -0.5),
        'attn_sink': nrm(ks[9], (DEPTH, N_Q), 1.0),
        'hgrn_lb': nrm(ks[10], (DEPTH, 2, HG_W), 1.0),
        'hgrn_norm_g': 1.0 + nrm(ks[11], (DEPTH, HG_W), 0.1),
        'conv_w': nrm(ks[12], (DEPTH, CONV_WIDTH, CV_W), CONV_WIDTH ** -0.5),
        'w_o': nrm(ks[13], (DEPTH, MIX_W, D_MODEL), MIX_W ** -0.5),
        'router_w': nrm(ks[14], (DEPTH, D_MODEL, N_EXPERTS), D_MODEL ** -0.5),
        'exp_w_gate': nrm(ks[15], (DEPTH, N_EXPERTS, D_MODEL, D_EXPERT), D_MODEL ** -0.5),
        'exp_w_up': nrm(ks[16], (DEPTH, N_EXPERTS, D_MODEL, D_EXPERT), D_MODEL ** -0.5),
        'exp_w_down': nrm(ks[17], (DEPTH, N_EXPERTS, D_EXPERT, D_MODEL), D_EXPERT ** -0.5),
        'final_norm_g': 1.0 + nrm(ks[18], (D_MODEL,), 0.1),
    }


def reference(x, c, ctx, c_ctx, ada_w, ada_b, norm1_g, norm2_g, w_in, attn_sink, hgrn_lb,
              hgrn_norm_g, conv_w, w_o, router_w, exp_w_gate, exp_w_up, exp_w_down, final_norm_g):
    n_rows = x.shape[1] // GRID_W
    cos, sin = axial_rope_tables(n_rows, x.dtype)
    gamma = jax.nn.softmax(hgrn_lb.astype(F32), axis=0)
    lb_all = jnp.cumsum(gamma, axis=0) - gamma[0]
    sc = jax.nn.silu(c)
    scc = jax.nn.silu(c_ctx)
    xl, xc = x, ctx
    for l in range(DEPTH):
        last = l == DEPTH - 1
        n_ctx_mod = 2 if last else N_MOD
        mod_l = [m[:, None, :] for m in jnp.split(sc @ ada_w[l] + ada_b[l], N_MOD, axis=-1)]
        mod_c = jnp.split(scc @ ada_w[l][:, :n_ctx_mod * D_MODEL] + ada_b[l][:n_ctx_mod * D_MODEL], n_ctx_mod, axis=-1)
        hl = modulate(rmsnorm(xl, norm1_g[l]), mod_l[0], mod_l[1])
        hc = modulate(rmsnorm(xc, norm1_g[l]), mod_c[0], mod_c[1])
        lb_f = lb_all[l, 0].reshape(HG_HEADS, HG_DIM)
        lb_b = lb_all[l, 1].reshape(HG_HEADS, HG_DIM)
        mix_l, mix_c = token_mixers(hl, hc, w_in[l], w_o[l], attn_sink[l], lb_f, lb_b,
                                    hgrn_norm_g[l], conv_w[l], cos, sin, not last)
        xl = xl + mod_l[2] * mix_l
        hl2 = modulate(rmsnorm(xl, norm2_g[l]), mod_l[3], mod_l[4])
        xl = xl + mod_l[5] * expert_choice_moe(hl2, router_w[l], exp_w_gate[l], exp_w_up[l], exp_w_down[l])
        if not last:
            xc = xc + mod_c[2] * mix_c
            hc2 = modulate(rmsnorm(xc, norm2_g[l]), mod_c[3], mod_c[4])
            xc = xc + mod_c[5] * expert_choice_moe(hc2, router_w[l], exp_w_gate[l], exp_w_up[l], exp_w_down[l])
    return rmsnorm(xl, final_norm_g)
```

```cpp
#include <hip/hip_runtime.h>
#include <cstdio>
#include <cstdint>

#ifndef MK_ONE_LAUNCH
#define MK_ONE_LAUNCH 0
#endif

typedef unsigned short bf16_t;
typedef short bf16x8 __attribute__((ext_vector_type(8)));
typedef float f32x4 __attribute__((ext_vector_type(4)));

namespace {
constexpr int D = 1024, NB = 4, T = 4096, L = 256, NLAT = NB * T, NCTX = NB * L, NROWS = NLAT + NCTX;
constexpr int INC = 2816;
constexpr int OFF_K = 0, OFF_V = 128, OFF_I = 256, OFF_FF = 512, OFF_FB = 768, OFF_Q = 1024, OFF_HQ = 1536, OFF_G = 1792, OFF_CB = 2048, OFF_CC = 2304, OFF_CH = 2560;
constexpr int NE = 16, DE = 2048, CAP_L = 512, CAP_C = 32, EROWS = 2304;
constexpr int NSC = 68;
constexpr int NMODV = 6 * D;
constexpr int NTHREADS = 512, NWAVES = 8;
constexpr int LDS_BYTES = 144 * 1024;
constexpr int NPHASES = 24;

constexpr size_t al(size_t x) { return (x + 4095) & ~(size_t)4095; }
constexpr size_t WS_CTL = 0;                                   constexpr size_t CTL_BYTES = 65536;
constexpr size_t WS_MOD = WS_CTL + CTL_BYTES;
constexpr size_t WS_COS = al(WS_MOD + (size_t)2 * 5 * NMODV * 4);
constexpr size_t WS_SIN = al(WS_COS + (size_t)T * 32 * 4);
constexpr size_t WS_AFF = al(WS_SIN + (size_t)T * 32 * 4);
constexpr size_t WS_SLOT = al(WS_AFF + (size_t)NROWS * 16 * 4);
constexpr size_t WS_ROWMAP = al(WS_SLOT + (size_t)NROWS * 16 * 4);
constexpr size_t WS_GATEV = al(WS_ROWMAP + (size_t)NE * EROWS * 4);
constexpr size_t WS_HD = al(WS_GATEV + (size_t)NE * EROWS * 4);
constexpr size_t WS_HU = al(WS_HD + (size_t)NB * 2 * NSC * 4 * 64 * 4);
constexpr size_t WS_SB = al(WS_HU + (size_t)NB * 2 * NSC * 4 * 4096 * 4);
constexpr size_t WS_OF = al(WS_SB + (size_t)NB * 2 * NSC * 4 * 4096 * 4);
constexpr size_t WS_X = al(WS_OF + (size_t)NROWS * 256 * 4);
constexpr size_t WS_HN = al(WS_X + (size_t)NROWS * D * 4);
constexpr size_t WS_PL = al(WS_HN + (size_t)NROWS * D * 2);
constexpr size_t WS_MIXIN = al(WS_PL + (size_t)NROWS * INC * 2);
constexpr size_t WS_HID = al(WS_MIXIN + (size_t)NROWS * D * 2);
constexpr size_t WS_Y = al(WS_HID + (size_t)NE * EROWS * DE * 2);
constexpr size_t WS_WIN = al(WS_Y + (size_t)NE * EROWS * D * 2);
constexpr size_t WS_WO = al(WS_WIN + (size_t)2 * INC * D * 2);
constexpr size_t WS_WGU = al(WS_WO + (size_t)2 * D * D * 2);
constexpr size_t WS_WD = al(WS_WGU + (size_t)2 * NE * 2 * DE * D * 2);
constexpr size_t WS_END = al(WS_WD + (size_t)2 * NE * D * DE * 2);

struct Args { const float* in[19]; float* out; unsigned char* ws; int ph_lo, ph_hi; };

struct Frame {
    unsigned char* lds;
    int tid, lane, wave, bid, G;
    const float *x, *c, *ctx, *c_ctx, *ada_w, *ada_b, *norm1_g, *norm2_g, *w_in, *attn_sink, *hgrn_lb, *hgrn_norm_g, *conv_w, *w_o, *router_w, *wg, *wu, *wd, *final_g;
    float* out;
    float *MOD, *COS, *SIN, *AFF, *GATEV, *HD, *HU, *SB, *OF, *X;
    int *SLOT, *ROWMAP;
    bf16_t *HN, *PL, *MIXIN, *HID, *Y, *WIN, *WO, *WGU, *WD;
};

__device__ __forceinline__ float bf2f(bf16_t b) { return __uint_as_float((unsigned)b << 16); }
__device__ __forceinline__ bf16_t f2bf(float f) { unsigned u = __float_as_uint(f); u += 0x7fffu + ((u >> 16) & 1u); return (bf16_t)(u >> 16); }
__device__ __forceinline__ unsigned pk2(float lo, float hi) { return (unsigned)f2bf(lo) | ((unsigned)f2bf(hi) << 16); }
__device__ __forceinline__ float wave_sum(float v) {
#pragma unroll
    for (int o = 1; o < 64; o <<= 1) v += __shfl_xor(v, o);
    return v;
}
__device__ __forceinline__ int wave_sum_i(int v) {
#pragma unroll
    for (int o = 1; o < 64; o <<= 1) v += __shfl_xor(v, o);
    return v;
}
__device__ __forceinline__ float sigmoidf_(float x) { return 1.f / (1.f + __expf(-x)); }
__device__ __forceinline__ float siluf_(float x) { return x / (1.f + __expf(-x)); }
__device__ __forceinline__ void wave_lds_sync() { asm volatile("s_waitcnt lgkmcnt(0)" ::: "memory"); }
__device__ __forceinline__ int modb(int r) { return r < NLAT ? (r >> 12) : 4; }
__device__ __forceinline__ int row_of_pos(int b, int pos) { return pos < L ? NLAT + b * L + pos : b * T + (pos - L); }
__device__ __forceinline__ float lb_val(const Frame& F, int l, int dir, int c) {
    if (l == 0) return 0.f;
    const float a0 = F.hgrn_lb[(0 * 2 + dir) * 256 + c], a1 = F.hgrn_lb[(1 * 2 + dir) * 256 + c];
    return 1.f / (1.f + expf(a0 - a1));
}

template <class RM>
__device__ __forceinline__ void transpose_item(const float* __restrict__ W, int K, int N, bf16_t* __restrict__ WT, RM rowmap, float* scr, int item, int lane) {
    const int nblk = N / 32, kb = item / nblk, nb = item % nblk, k0 = 64 * kb, n0 = 32 * nb;
#pragma unroll 8
    for (int i = 0; i < 32; ++i) { const int kk = 2 * i + (lane >> 5); scr[kk * 33 + (lane & 31)] = W[(size_t)(k0 + kk) * N + n0 + (lane & 31)]; }
    wave_lds_sync();
    const int c = lane & 7;
#pragma unroll
    for (int j = 0; j < 4; ++j) {
        const int n = (lane >> 3) + 8 * j; const float* s = scr + (8 * c) * 33 + n;
        uint4 o; o.x = pk2(s[0 * 33], s[1 * 33]); o.y = pk2(s[2 * 33], s[3 * 33]); o.z = pk2(s[4 * 33], s[5 * 33]); o.w = pk2(s[6 * 33], s[7 * 33]);
        *(uint4*)(WT + (size_t)rowmap(n0 + n) * K + k0 + 8 * c) = o;
    }
    wave_lds_sync();
}
struct RMId { __device__ __forceinline__ int operator()(int n) const { return n; } };
struct RMGate { __device__ __forceinline__ int operator()(int n) const { return (n >> 7) * 256 + (n & 127); } };
struct RMUp { __device__ __forceinline__ int operator()(int n) const { return (n >> 7) * 256 + 128 + (n & 127); } };

__device__ __forceinline__ void phase_pre(const Frame& F) {
    float* s_l = (float*)F.lds;
    float* red = s_l + 5 * 1024;
    for (int i = F.tid; i < 5 * 1024; i += NTHREADS) { const int b = i >> 10, k = i & 1023; const float c = b < 4 ? F.c[b * 1024 + k] : F.c_ctx[k]; s_l[i] = c / (1.f + expf(-c)); }
    __syncthreads();
    for (int item = F.bid; item < 192; item += F.G) {
        const int l = item / 96, n0 = (item % 96) * 64, kq = F.tid >> 6, n = F.tid & 63;
        float acc[5] = {0.f, 0.f, 0.f, 0.f, 0.f};
        const float* W = F.ada_w + (size_t)l * D * NMODV + n0 + n;
        for (int kk = 0; kk < 128; ++kk) { const int k = kq * 128 + kk; const float w = W[(size_t)k * NMODV];
#pragma unroll
            for (int b = 0; b < 5; ++b) acc[b] += s_l[b * 1024 + k] * w; }
#pragma unroll
        for (int b = 0; b < 5; ++b) red[(kq * 5 + b) * 64 + n] = acc[b];
        __syncthreads();
        if (F.tid < 320) { const int b = F.tid >> 6; float s = 0.f;
#pragma unroll
            for (int q = 0; q < 8; ++q) s += red[(q * 5 + b) * 64 + n];
            F.MOD[(size_t)(l * 5 + b) * NMODV + n0 + n] = s + F.ada_b[l * NMODV + n0 + n]; }
        __syncthreads();
    }
    for (int i = F.bid * NTHREADS + F.tid; i < T * 32; i += F.G * NTHREADS) {
        const int t = i >> 5, a = (i >> 4) & 1, f = i & 15; const float pos = (float)(a == 0 ? (t >> 6) : (t & 63));
        const float inv = powf(10000.f, -(float)f / 16.f); const float ang = pos * inv;
        F.COS[i] = cosf(ang); F.SIN[i] = sinf(ang);
    }
    float* scr = (float*)F.lds + F.wave * (64 * 33);
    __syncthreads();
    constexpr int I_IN = 16 * 88, I_O = 16 * 32, I_G = 16 * 64, I_D = 32 * 32;
    constexpr int PER_L = I_IN + I_O + 16 * (2 * I_G + I_D);
    const int gw = F.bid * NWAVES + F.wave, NGW = F.G * NWAVES;
    for (int it = gw; it < 2 * PER_L; it += NGW) {
        const int l = it / PER_L; int r = it % PER_L;
        if (r < I_IN) { transpose_item(F.w_in + (size_t)l * D * INC, D, INC, F.WIN + (size_t)l * INC * D, RMId(), scr, r, F.lane); continue; } r -= I_IN;
        if (r < I_O) { transpose_item(F.w_o + (size_t)l * D * D, D, D, F.WO + (size_t)l * D * D, RMId(), scr, r, F.lane); continue; } r -= I_O;
        const int e = r / (2 * I_G + I_D); r %= (2 * I_G + I_D);
        const size_t le = (size_t)l * NE + e;
        if (r < I_G) { transpose_item(F.wg + le * D * DE, D, DE, F.WGU + le * 2 * DE * D, RMGate(), scr, r, F.lane); continue; } r -= I_G;
        if (r < I_G) { transpose_item(F.wu + le * D * DE, D, DE, F.WGU + le * 2 * DE * D, RMUp(), scr, r, F.lane); continue; } r -= I_G;
        transpose_item(F.wd + le * DE * D, DE, D, F.WD + le * D * DE, RMId(), scr, r, F.lane);
    }
}

template <int MODE>
__device__ __forceinline__ void phase_norm1(const Frame& F) {
    const int gw = F.bid * NWAVES + F.wave, NGW = F.G * NWAVES, lane = F.lane;
    const int nrows = MODE == 2 ? NLAT : NROWS;
    const int lprev = MODE == 1 ? 0 : 1;
    const int lcur = MODE == 0 ? 0 : 1;
    for (int r = gw; r < nrows; r += NGW) {
        const int mb = modb(r);
        f32x4 v[4];
        const float* src = MODE == 0 ? (r < NLAT ? F.x + (size_t)r * D : F.ctx + (size_t)(r - NLAT) * D) : F.X + (size_t)r * D;
#pragma unroll
        for (int j = 0; j < 4; ++j) v[j] = *(const f32x4*)(src + lane * 4 + 256 * j);
        if (MODE != 0) {
            f32x4 acc[4];
#pragma unroll
            for (int j = 0; j < 4; ++j) acc[j] = (f32x4){0.f, 0.f, 0.f, 0.f};
            for (int e = 0; e < NE; ++e) {
                const int s = F.SLOT[(size_t)r * 16 + e];
                if (s >= 0) {
                    const float g = F.GATEV[e * EROWS + s];
                    const bf16_t* y = F.Y + ((size_t)e * EROWS + s) * D;
#pragma unroll
                    for (int j = 0; j < 4; ++j) { const uint2 w = *(const uint2*)(y + lane * 4 + 256 * j);
                        acc[j].x += g * __uint_as_float(w.x << 16); acc[j].y += g * __uint_as_float(w.x & 0xffff0000u);
                        acc[j].z += g * __uint_as_float(w.y << 16); acc[j].w += g * __uint_as_float(w.y & 0xffff0000u); }
                }
            }
            const float* g2 = F.MOD + (size_t)(lprev * 5 + mb) * NMODV + 5 * D;
#pragma unroll
            for (int j = 0; j < 4; ++j) { const f32x4 gg = *(const f32x4*)(g2 + lane * 4 + 256 * j); v[j] += gg * acc[j]; }
        }
        if (MODE != 2) {
#pragma unroll
            for (int j = 0; j < 4; ++j) *(f32x4*)(F.X + (size_t)r * D + lane * 4 + 256 * j) = v[j];
        }
        float ss = 0.f;
#pragma unroll
        for (int j = 0; j < 4; ++j) ss += (v[j].x * v[j].x + v[j].y * v[j].y) + (v[j].z * v[j].z + v[j].w * v[j].w);
        ss = wave_sum(ss);
        const float rstd = rsqrtf(ss * (1.f / D) + 1e-6f);
        if (MODE == 2) {
#pragma unroll
            for (int j = 0; j < 4; ++j) { const f32x4 g = *(const f32x4*)(F.final_g + lane * 4 + 256 * j); *(f32x4*)(F.out + (size_t)r * D + lane * 4 + 256 * j) = v[j] * rstd * g; }
        } else {
            const float* mv = F.MOD + (size_t)(lcur * 5 + mb) * NMODV;
#pragma unroll
            for (int j = 0; j < 4; ++j) {
                const int c0 = lane * 4 + 256 * j;
                const f32x4 g = *(const f32x4*)(F.norm1_g + lcur * D + c0), sh = *(const f32x4*)(mv + c0), sc = *(const f32x4*)(mv + D + c0);
                const f32x4 h = v[j] * rstd * g * (sc + 1.f) + sh;
                uint2 w; w.x = pk2(h.x, h.y); w.y = pk2(h.z, h.w);
                *(uint2*)(F.HN + (size_t)r * D + c0) = w;
            }
        }
    }
}

template <class Epi>
__device__ __forceinline__ void gemm_tile_simple(const bf16_t* __restrict__ A, int lda, const bf16_t* __restrict__ Bt, int K, int m0, int n0, int wave, int lane, const Epi& epi) {
    const int wr = wave >> 1, wc = wave & 1, fr = lane & 15, fq = lane >> 4;
    const bf16_t* ap[4]; const bf16_t* bp[4];
#pragma unroll
    for (int i = 0; i < 4; ++i) ap[i] = A + (size_t)(m0 + wr * 64 + i * 16 + fr) * lda + fq * 8;
#pragma unroll
    for (int j = 0; j < 4; ++j) bp[j] = Bt + (size_t)(n0 + wc * 64 + j * 16 + fr) * K + fq * 8;
    f32x4 acc[4][4];
#pragma unroll
    for (int i = 0; i < 4; ++i)
#pragma unroll
        for (int j = 0; j < 4; ++j) acc[i][j] = (f32x4){0.f, 0.f, 0.f, 0.f};
    for (int k0 = 0; k0 < K; k0 += 32) {
        bf16x8 a[4], b[4];
#pragma unroll
        for (int i = 0; i < 4; ++i) a[i] = *(const bf16x8*)(ap[i] + k0);
#pragma unroll
        for (int j = 0; j < 4; ++j) b[j] = *(const bf16x8*)(bp[j] + k0);
#pragma unroll
        for (int i = 0; i < 4; ++i)
#pragma unroll
            for (int j = 0; j < 4; ++j) acc[i][j] = __builtin_amdgcn_mfma_f32_16x16x32_bf16(b[j], a[i], acc[i][j], 0, 0, 0);
    }
#pragma unroll
    for (int i = 0; i < 4; ++i)
#pragma unroll
        for (int j = 0; j < 4; ++j) epi(m0 + wr * 64 + i * 16 + fr, n0 + wc * 64 + j * 16 + fq * 4, acc[i][j]);
}

__device__ __forceinline__ void phase_gemm_in(const Frame& F, int l) {
    const bf16_t* Bt = F.WIN + (size_t)l * INC * D;
    bf16_t* PL = F.PL;
    auto epi = [PL](int m, int n, f32x4 v) { uint2 w; w.x = pk2(v.x, v.y); w.y = pk2(v.z, v.w); *(uint2*)(PL + (size_t)m * INC + n) = w; };
    const int ntn = INC / 128, ntm = NROWS / 256;
    for (int it = F.bid; it < ntm * ntn; it += F.G) gemm_tile_simple(F.HN, D, Bt, D, (it / ntn) * 256, (it % ntn) * 128, F.wave, F.lane, epi);
}

__device__ __forceinline__ void phase_gemm_o(const Frame& F, int l) {
    const bf16_t* Bt = F.WO + (size_t)l * D * D;
    float* X = F.X; const float* MODl = F.MOD + (size_t)l * 5 * NMODV + 2 * D;
    auto epi = [X, MODl](int m, int n, f32x4 v) { const f32x4 g = *(const f32x4*)(MODl + (size_t)modb(m) * NMODV + n); f32x4* xp = (f32x4*)(X + (size_t)m * D + n); *xp = *xp + g * v; };
    const int ntn = D / 128, ntm = (l == 0 ? NROWS : NLAT) / 256;
    for (int it = F.bid; it < ntm * ntn; it += F.G) gemm_tile_simple(F.MIXIN, D, Bt, D, (it / ntn) * 256, (it % ntn) * 128, F.wave, F.lane, epi);
}

__device__ __forceinline__ void phase_gemm2(const Frame& F, int l) {
    const int RT = l == 0 ? 9 : 8, ntn = D / 128;
    for (int it = F.bid; it < NE * RT * ntn; it += F.G) {
        const int e = it / (RT * ntn), rt = (it / ntn) % RT, ct = it % ntn;
        bf16_t* Ye = F.Y + (size_t)e * EROWS * D;
        auto epi = [Ye](int m, int n, f32x4 v) { uint2 w; w.x = pk2(v.x, v.y); w.y = pk2(v.z, v.w); *(uint2*)(Ye + (size_t)m * D + n) = w; };
        gemm_tile_simple(F.HID + (size_t)e * EROWS * DE, DE, F.WD + ((size_t)l * NE + e) * D * DE, DE, rt * 256, ct * 128, F.wave, F.lane, epi);
    }
}

__device__ __forceinline__ void phase_gemm1(const Frame& F, int l) {
    const int RT = l == 0 ? 9 : 8, ntn = DE / 64;
    const int wr = F.wave >> 1, wc = F.wave & 1, fr = F.lane & 15, fq = F.lane >> 4;
    for (int it = F.bid; it < NE * RT * ntn; it += F.G) {
        const int e = it / (RT * ntn), rt = (it / ntn) % RT, ct = it % ntn;
        const bf16_t* Bt = F.WGU + ((size_t)l * NE + e) * 2 * DE * D;
        const bf16_t* ap[4]; const bf16_t* bg[2]; const bf16_t* bu[2];
#pragma unroll
        for (int i = 0; i < 4; ++i) { const int m = rt * 256 + wr * 64 + i * 16 + fr; ap[i] = F.HN + (size_t)F.ROWMAP[e * EROWS + m] * D + fq * 8; }
#pragma unroll
        for (int j = 0; j < 2; ++j) { const int col = ct * 64 + wc * 32 + j * 16 + fr; const int grow = (col >> 7) * 256 + (col & 127); bg[j] = Bt + (size_t)grow * D + fq * 8; bu[j] = Bt + (size_t)(grow + 128) * D + fq * 8; }
        f32x4 ag[4][2], au[4][2];
#pragma unroll
        for (int i = 0; i < 4; ++i)
#pragma unroll
            for (int j = 0; j < 2; ++j) { ag[i][j] = (f32x4){0.f, 0.f, 0.f, 0.f}; au[i][j] = (f32x4){0.f, 0.f, 0.f, 0.f}; }
        for (int k0 = 0; k0 < D; k0 += 32) {
            bf16x8 a[4], g[2], u[2];
#pragma unroll
            for (int i = 0; i < 4; ++i) a[i] = *(const bf16x8*)(ap[i] + k0);
#pragma unroll
            for (int j = 0; j < 2; ++j) { g[j] = *(const bf16x8*)(bg[j] + k0); u[j] = *(const bf16x8*)(bu[j] + k0); }
#pragma unroll
            for (int i = 0; i < 4; ++i)
#pragma unroll
                for (int j = 0; j < 2; ++j) { ag[i][j] = __builtin_amdgcn_mfma_f32_16x16x32_bf16(g[j], a[i], ag[i][j], 0, 0, 0); au[i][j] = __builtin_amdgcn_mfma_f32_16x16x32_bf16(u[j], a[i], au[i][j], 0, 0, 0); }
        }
#pragma unroll
        for (int i = 0; i < 4; ++i)
#pragma unroll
            for (int j = 0; j < 2; ++j) {
                const int m = rt * 256 + wr * 64 + i * 16 + fr, col = ct * 64 + wc * 32 + j * 16 + fq * 4;
                const f32x4 gg = ag[i][j], uu = au[i][j];
                uint2 w; w.x = pk2(siluf_(gg.x) * uu.x, siluf_(gg.y) * uu.y); w.y = pk2(siluf_(gg.z) * uu.z, siluf_(gg.w) * uu.w);
                *(uint2*)(F.HID + ((size_t)e * EROWS + m) * DE + col) = w;
            }
    }
}

__device__ __forceinline__ void phase_prep(const Frame& F) {
    const int gw = F.bid * NWAVES + F.wave, NGW = F.G * NWAVES;
    for (int r = gw; r < NLAT; r += NGW) {
        const int t = r & (T - 1);
        bf16_t* row = F.PL + (size_t)r * INC;
#pragma unroll
        for (int it = 0; it < 5; ++it) {
            const int p = it * 64 + F.lane, head = p >> 5, w = p & 31, a = w >> 4, f = w & 15;
            const int cb = (head < 8 ? OFF_Q + head * 64 : OFF_K + (head - 8) * 64) + a * 32 + f;
            const float x1 = bf2f(row[cb]), x2 = bf2f(row[cb + 16]);
            const float c = F.COS[t * 32 + a * 16 + f], s = F.SIN[t * 32 + a * 16 + f];
            row[cb] = f2bf(x1 * c - x2 * s); row[cb + 16] = f2bf(x2 * c + x1 * s);
        }
    }
}

__device__ __forceinline__ void attn_item(const Frame& F, int l, int item, int lane) {
    const bool is_ctx = item >= 2048;
    int b, h, qb;
    if (!is_ctx) { qb = item & 63; h = (item >> 6) & 7; b = item >> 9; } else { const int it = item - 2048; qb = it & 3; h = (it >> 2) & 7; b = it >> 5; }
    const int kv = h >> 2;
    const int qrow = is_ctx ? NLAT + b * L + qb * 64 + lane : b * T + qb * 64 + lane;
    float q[64], o[64];
    {
        const bf16_t* qp = F.PL + (size_t)qrow * INC + OFF_Q + h * 64;
#pragma unroll
        for (int d8 = 0; d8 < 8; ++d8) { const uint4 w = *(const uint4*)(qp + d8 * 8); const unsigned ww[4] = {w.x, w.y, w.z, w.w};
#pragma unroll
            for (int k = 0; k < 4; ++k) { q[d8 * 8 + 2 * k] = __uint_as_float(ww[k] << 16) * 0.125f; q[d8 * 8 + 2 * k + 1] = __uint_as_float(ww[k] & 0xffff0000u) * 0.125f; } }
    }
#pragma unroll
    for (int d = 0; d < 64; ++d) o[d] = 0.f;
    float m = -1e30f, lsum = 0.f;
    auto step = [&](int krow, bool valid) {
        const bf16_t* kp = F.PL + (size_t)krow * INC + OFF_K + kv * 64;
        const bf16_t* vp = F.PL + (size_t)krow * INC + OFF_V + kv * 64;
        float s = 0.f;
#pragma unroll
        for (int d2 = 0; d2 < 32; ++d2) { const unsigned w = *(const unsigned*)(kp + 2 * d2); s += q[2 * d2] * __uint_as_float(w << 16) + q[2 * d2 + 1] * __uint_as_float(w & 0xffff0000u); }
        if (valid && s > m) { const float corr = __expf(m - s); lsum *= corr;
#pragma unroll
            for (int d = 0; d < 64; ++d) o[d] *= corr;
            m = s; }
        const float p = valid ? __expf(s - m) : 0.f;
        lsum += p;
#pragma unroll
        for (int d2 = 0; d2 < 32; ++d2) { const unsigned w = *(const unsigned*)(vp + 2 * d2); o[2 * d2] += p * __uint_as_float(w << 16); o[2 * d2 + 1] += p * __uint_as_float(w & 0xffff0000u); }
    };
    if (!is_ctx) {
        const int t = qb * 64 + lane; const int j0 = qb * 64 - 128 < 0 ? 0 : qb * 64 - 128, j1 = qb * 64 + 192 > T ? T : qb * 64 + 192;
        for (int j = j0; j < j1; ++j) { const int dlt = t - j; step(b * T + j, dlt <= 128 && dlt >= -128); }
    }
    for (int j = 0; j < L; ++j) step(NLAT + b * L + j, true);
    {
        const float sk = F.attn_sink[l * 8 + h];
        if (sk > m) { const float corr = __expf(m - sk); lsum *= corr;
#pragma unroll
            for (int d = 0; d < 64; ++d) o[d] *= corr;
            m = sk; }
        lsum += __expf(sk - m);
    }
    const float inv = 1.f / lsum;
    bf16_t* op = F.MIXIN + (size_t)qrow * D + h * 64;
#pragma unroll
    for (int d8 = 0; d8 < 8; ++d8) { uint4 w; w.x = pk2(o[d8 * 8] * inv, o[d8 * 8 + 1] * inv); w.y = pk2(o[d8 * 8 + 2] * inv, o[d8 * 8 + 3] * inv); w.z = pk2(o[d8 * 8 + 4] * inv, o[d8 * 8 + 5] * inv); w.w = pk2(o[d8 * 8 + 6] * inv, o[d8 * 8 + 7] * inv); *(uint4*)(op + d8 * 8) = w; }
}

__device__ __forceinline__ int hg_row(int b, int j, int dir, int tau) { const int pos = 64 * j + (dir ? 63 - tau : tau); return row_of_pos(b, pos); }

__device__ __forceinline__ void hgrn_a_item(const Frame& F, int l, int item, int lane, float* wl) {
    const int dir = item & 1, h = (item >> 1) & 3, j = (item >> 3) % NSC, b = item / (8 * NSC);
    float* kd = wl; float* dec = wl + 1024;
    const float lb = lb_val(F, l, dir, h * 64 + lane);
    const int zoff = (dir ? OFF_FB : OFF_FF) + h * 64 + lane, voff = OFF_I + h * 64 + lane;
    float acc[64];
#pragma unroll
    for (int d = 0; d < 64; ++d) acc[d] = 0.f;
    float Dacc = 1.f;
    for (int c = 0; c < 4; ++c) {
        float k[16], lam[16]; float run = 0.f;
#pragma unroll
        for (int tau = 0; tau < 16; ++tau) {
            const int row = hg_row(b, j, dir, c * 16 + tau);
            const float z = bf2f(F.PL[(size_t)row * INC + zoff]);
            k[tau] = (1.f - lb) * sigmoidf_(-z);
            const float lf = fmaxf(log1pf(-k[tau]), -69.f);
            run += lf; lam[tau] = run;
        }
        wave_lds_sync();
#pragma unroll
        for (int tau = 0; tau < 16; ++tau) kd[tau * 64 + lane] = k[tau] * __expf(run - lam[tau]);
        const float dc = __expf(run); dec[lane] = dc; Dacc *= dc;
        wave_lds_sync();
#pragma unroll
        for (int d = 0; d < 64; ++d) acc[d] *= dec[d];
#pragma unroll
        for (int tau = 0; tau < 16; ++tau) {
            const int row = hg_row(b, j, dir, c * 16 + tau);
            const float vv = bf2f(F.PL[(size_t)row * INC + voff]);
#pragma unroll
            for (int d = 0; d < 64; ++d) acc[d] += kd[tau * 64 + d] * vv;
        }
    }
    const size_t base = (size_t)(((b * 2 + dir) * NSC + j) * 4 + h);
    float* Uo = F.HU + base * 4096;
#pragma unroll
    for (int d = 0; d < 64; ++d) Uo[d * 64 + lane] = acc[d];
    F.HD[base * 64 + lane] = Dacc;
    wave_lds_sync();
}

__device__ __forceinline__ void phase_hgrn_b(const Frame& F) {
    const float* __restrict__ HU = F.HU; const float* __restrict__ HD = F.HD; float* __restrict__ SB = F.SB;
    for (int idx = F.bid * NTHREADS + F.tid; idx < NB * 2 * 4 * 4096; idx += F.G * NTHREADS) {
        const int v = idx & 63, d = (idx >> 6) & 63, h = (idx >> 12) & 3, dir = (idx >> 14) & 1, b = idx >> 15;
        float S = 0.f;
#pragma unroll 4
        for (int p = 0; p < NSC; ++p) {
            const int j = dir ? (p < 4 ? 3 - p : 71 - p) : p;
            const size_t base = (size_t)(((b * 2 + dir) * NSC + j) * 4 + h);
            const float u = HU[base * 4096 + d * 64 + v], dd = HD[base * 64 + d];
            SB[base * 4096 + d * 64 + v] = S;
            S = dd * S + u;
        }
    }
}

__device__ __forceinline__ void hgrn_c_item(const Frame& F, int l, int item, int lane, float* wl) {
    const int h = item & 3, j = (item >> 2) % NSC, b = item / (4 * NSC);
    float* qe = wl; float* kd = wl + 1024; float* Am = wl + 2048; float* dec = wl + 2304;
    const int voff = OFF_I + h * 64 + lane, qoff = OFF_HQ + h * 64 + lane, goff = OFF_G + h * 64 + lane;
    const float gain = F.hgrn_norm_g[l * 256 + h * 64 + lane];
    for (int dir = 0; dir < 2; ++dir) {
        const float lb = lb_val(F, l, dir, h * 64 + lane);
        const int zoff = (dir ? OFF_FB : OFF_FF) + h * 64 + lane;
        const size_t base = (size_t)(((b * 2 + dir) * NSC + j) * 4 + h);
        float S[64];
#pragma unroll
        for (int d = 0; d < 64; ++d) S[d] = F.SB[base * 4096 + d * 64 + lane];
        for (int c = 0; c < 4; ++c) {
            float k[16], lam[16], q[16]; float run = 0.f;
#pragma unroll
            for (int tau = 0; tau < 16; ++tau) {
                const int row = hg_row(b, j, dir, c * 16 + tau);
                const float z = bf2f(F.PL[(size_t)row * INC + zoff]);
                k[tau] = (1.f - lb) * sigmoidf_(-z);
                const float lf = fmaxf(log1pf(-k[tau]), -69.f);
                run += lf; lam[tau] = run;
                q[tau] = siluf_(bf2f(F.PL[(size_t)row * INC + qoff]));
            }
            wave_lds_sync();
#pragma unroll
            for (int tau = 0; tau < 16; ++tau) { qe[tau * 64 + lane] = q[tau] * __expf(lam[tau]); kd[tau * 64 + lane] = k[tau] * __expf(run - lam[tau]); }
            dec[lane] = __expf(run);
#pragma unroll
            for (int tau = 0; tau < 16; ++tau)
#pragma unroll
                for (int sg = 0; sg <= tau; ++sg) {
                    float xx = q[tau] * k[sg] * __expf(lam[tau] - lam[sg]);
                    xx = wave_sum(xx);
                    if (lane == 0) Am[tau * 16 + sg] = xx;
                }
            wave_lds_sync();
            float val[16];
#pragma unroll
            for (int sg = 0; sg < 16; ++sg) { const int row = hg_row(b, j, dir, c * 16 + sg); val[sg] = bf2f(F.PL[(size_t)row * INC + voff]); }
#pragma unroll
            for (int tau = 0; tau < 16; ++tau) {
                float o = 0.f;
#pragma unroll
                for (int sg = 0; sg <= tau; ++sg) o += Am[tau * 16 + sg] * val[sg];
#pragma unroll
                for (int d = 0; d < 64; ++d) o += qe[tau * 64 + d] * S[d];
                const int row = hg_row(b, j, dir, c * 16 + tau);
                float* ofp = F.OF + (size_t)row * 256 + h * 64 + lane;
                if (dir == 0) *ofp = o;
                else {
                    o += *ofp;
                    const float ss = wave_sum(o * o);
                    const float rstd = rsqrtf(ss * (1.f / 64.f) + 1e-6f);
                    const float g = bf2f(F.PL[(size_t)row * INC + goff]);
                    F.MIXIN[(size_t)row * D + 512 + h * 64 + lane] = f2bf(o * rstd * gain * siluf_(g));
                }
            }
#pragma unroll
            for (int d = 0; d < 64; ++d) { float s = dec[d] * S[d];
#pragma unroll
                for (int sg = 0; sg < 16; ++sg) s += kd[sg * 64 + d] * val[sg];
                S[d] = s; }
        }
    }
    wave_lds_sync();
}

__device__ __forceinline__ void conv_rows(const Frame& F, int l, int r0, int r1, int tid_in, int nthr) {
    for (int idx = r0 * 256 + tid_in; idx < r1 * 256; idx += nthr) {
        const int r = idx >> 8, c = idx & 255;
        int tt, len; if (r < NLAT) { tt = r & (T - 1); len = T; } else { tt = (r - NLAT) & (L - 1); len = L; }
        const bf16_t* row = F.PL + (size_t)r * INC;
        const float w0 = F.conv_w[(l * 3 + 0) * 256 + c], w1 = F.conv_w[(l * 3 + 1) * 256 + c], w2 = F.conv_w[(l * 3 + 2) * 256 + c];
        float u0 = 0.f, u2 = 0.f;
        const float u1 = bf2f(row[OFF_CC + c]) * bf2f(row[OFF_CH + c]);
        if (tt > 0) u0 = bf2f(row[OFF_CC + c - INC]) * bf2f(row[OFF_CH + c - INC]);
        if (tt < len - 1) u2 = bf2f(row[OFF_CC + c + INC]) * bf2f(row[OFF_CH + c + INC]);
        F.MIXIN[(size_t)r * D + 768 + c] = f2bf(bf2f(row[OFF_CB + c]) * (w0 * u0 + w1 * u1 + w2 * u2));
    }
}

__device__ __forceinline__ void phase_mix_a(const Frame& F, int l) {
    const int gw = F.bid * NWAVES + F.wave, NGW = F.G * NWAVES;
    float* wl = (float*)F.lds + F.wave * 2560;
    for (int it = gw; it < NB * NSC * 4 * 2; it += NGW) hgrn_a_item(F, l, it, F.lane, wl);
    conv_rows(F, l, 0, l == 0 ? NROWS : NLAT, F.bid * NTHREADS + F.tid, F.G * NTHREADS);
    const int nat = l == 0 ? 2048 + 128 : 2048;
    for (int it = gw; it < nat; it += NGW) attn_item(F, l, it, F.lane);
}

__device__ __forceinline__ void phase_hgrn_c(const Frame& F, int l) {
    const int gw = F.bid * NWAVES + F.wave, NGW = F.G * NWAVES;
    float* wl = (float*)F.lds + F.wave * 2560;
    for (int it = gw; it < NB * NSC * 4; it += NGW) { const int j = (it >> 2) % NSC; if (l == 1 && j < 4) continue; hgrn_c_item(F, l, it, F.lane, wl); }
}

__device__ __forceinline__ void phase_norm2(const Frame& F, int l) {
    const int gw = F.bid * NWAVES + F.wave, NGW = F.G * NWAVES, lane = F.lane;
    const int nrows = l == 0 ? NROWS : NLAT;
    const float* RW = F.router_w + (size_t)l * D * NE;
    for (int r = gw; r < nrows; r += NGW) {
        const int mb = modb(r);
        f32x4 v[4]; float ss = 0.f;
#pragma unroll
        for (int j = 0; j < 4; ++j) { v[j] = *(const f32x4*)(F.X + (size_t)r * D + lane * 4 + 256 * j); ss += (v[j].x * v[j].x + v[j].y * v[j].y) + (v[j].z * v[j].z + v[j].w * v[j].w); }
        ss = wave_sum(ss);
        const float rstd = rsqrtf(ss * (1.f / D) + 1e-6f);
        const float* mv = F.MOD + (size_t)(l * 5 + mb) * NMODV;
        float lg[16];
#pragma unroll
        for (int e = 0; e < 16; ++e) lg[e] = 0.f;
#pragma unroll
        for (int j = 0; j < 4; ++j) {
            const int c0 = lane * 4 + 256 * j;
            const f32x4 g = *(const f32x4*)(F.norm2_g + l * D + c0), sh = *(const f32x4*)(mv + 3 * D + c0), sc = *(const f32x4*)(mv + 4 * D + c0);
            const f32x4 h = v[j] * rstd * g * (sc + 1.f) + sh;
            uint2 w; w.x = pk2(h.x, h.y); w.y = pk2(h.z, h.w);
            *(uint2*)(F.HN + (size_t)r * D + c0) = w;
            const float hh[4] = {h.x, h.y, h.z, h.w};
#pragma unroll
            for (int i = 0; i < 4; ++i) {
                const f32x4* rw = (const f32x4*)(RW + (size_t)(c0 + i) * NE);
#pragma unroll
                for (int e4 = 0; e4 < 4; ++e4) { const f32x4 w4 = rw[e4]; lg[e4 * 4 + 0] += hh[i] * w4.x; lg[e4 * 4 + 1] += hh[i] * w4.y; lg[e4 * 4 + 2] += hh[i] * w4.z; lg[e4 * 4 + 3] += hh[i] * w4.w; }
            }
        }
        float mx = -1e30f;
#pragma unroll
        for (int e = 0; e < 16; ++e) { lg[e] = wave_sum(lg[e]); mx = fmaxf(mx, lg[e]); }
        float den = 0.f;
#pragma unroll
        for (int e = 0; e < 16; ++e) { lg[e] = expf(lg[e] - mx); den += lg[e]; }
        const float inv = 1.f / den;
        float mine = 0.f;
#pragma unroll
        for (int e = 0; e < 16; ++e) if (lane == e) mine = lg[e] * inv;
        if (lane < 16) F.AFF[(size_t)r * 16 + lane] = mine;
    }
}

__device__ __forceinline__ void topk_item(const Frame& F, int item) {
    const bool lat = item < 64; const int it = lat ? item : item - 64; const int b = it >> 4, e = it & 15;
    const int N = lat ? T : L, cap = lat ? CAP_L : CAP_C, rowbase = lat ? b * T : NLAT + b * L, mbase = lat ? b * CAP_L : 4 * CAP_L + b * CAP_C;
    const int ept = lat ? 8 : 1; const int nact = N / ept; const bool act = F.tid < nact;
    unsigned* wc = (unsigned*)F.lds;
    unsigned ku[8];
#pragma unroll
    for (int i = 0; i < 8; ++i) ku[i] = 0u;
    if (act) {
#pragma unroll
        for (int i = 0; i < 8; ++i) if (i < ept) ku[i] = __float_as_uint(F.AFF[(size_t)(rowbase + F.tid * ept + i) * 16 + e]);
    }
    unsigned thr = 0u;
    for (int bit = 30; bit >= 0; --bit) {
        const unsigned cand = thr | (1u << bit);
        int c = 0;
        if (act) {
#pragma unroll
            for (int i = 0; i < 8; ++i) if (i < ept) c += (ku[i] >= cand) ? 1 : 0;
        }
        c = wave_sum_i(c);
        if (F.lane == 0) wc[F.wave] = (unsigned)c;
        __syncthreads();
        unsigned tot = 0;
#pragma unroll
        for (int w = 0; w < NWAVES; ++w) tot += wc[w];
        if ((int)tot >= cap) thr = cand;
        __syncthreads();
    }
    unsigned cg = 0, ce = 0;
    if (act) {
#pragma unroll
        for (int i = 0; i < 8; ++i) if (i < ept) { cg += (ku[i] > thr) ? 1u : 0u; ce += (ku[i] == thr) ? 1u : 0u; }
    }
    unsigned pk = cg | (ce << 16), inc = pk;
#pragma unroll
    for (int o = 1; o < 64; o <<= 1) { const unsigned t = __shfl_up(inc, o); if (F.lane >= o) inc += t; }
    if (F.lane == 63) wc[F.wave] = inc;
    __syncthreads();
    unsigned pre = 0, total = 0;
#pragma unroll
    for (int w = 0; w < NWAVES; ++w) { const unsigned t = wc[w]; if (w < F.wave) pre += t; total += t; }
    __syncthreads();
    unsigned excl = pre + inc - pk;
    unsigned pg = excl & 0xffffu, pe = excl >> 16; const unsigned tg = total & 0xffffu; const unsigned need = (unsigned)cap - tg;
    if (act) {
#pragma unroll
        for (int i = 0; i < 8; ++i) if (i < ept) {
            const int row = rowbase + F.tid * ept + i; int slot = -1;
            if (ku[i] > thr) slot = (int)pg++;
            else if (ku[i] == thr) { if (pe < need) slot = (int)(tg + pe); ++pe; }
            int mm = -1;
            if (slot >= 0) { mm = mbase + slot; F.ROWMAP[e * EROWS + mm] = row; F.GATEV[e * EROWS + mm] = __uint_as_float(ku[i]); }
            F.SLOT[(size_t)row * 16 + e] = mm;
        }
    }
    if (!lat && b == 0) { for (int i = F.tid; i < EROWS - (4 * CAP_L + 4 * CAP_C); i += NTHREADS) { F.ROWMAP[e * EROWS + 4 * CAP_L + 4 * CAP_C + i] = 0; F.GATEV[e * EROWS + 4 * CAP_L + 4 * CAP_C + i] = 0.f; } }
}

__device__ __forceinline__ void phase_topk(const Frame& F, int l) {
    const int n = l == 0 ? 128 : 64;
    for (int it = F.bid; it < n; it += F.G) { topk_item(F, it); __syncthreads(); }
}

#define XB_TMO      128
#define XB_XCNT(j)  (256  + 64 * (j))
#define XB_XSUB(j)  (1280 + 64 * (j))
#define XB_XGEN(j)  (2304 + 64 * (j))
#define XB_TOP      3328
#define XB_TOPGEN   3392
#define XCD_BAR_WORDS 3456
#define XB_SPIN_CAP (1u << 20)
#define LAS __attribute__((address_space(3)))
__device__ __forceinline__ unsigned xb_ld(unsigned* p)              { return __hip_atomic_load(p, __ATOMIC_RELAXED, __HIP_MEMORY_SCOPE_AGENT); }
__device__ __forceinline__ unsigned xb_add(unsigned* p, unsigned v) { return __hip_atomic_fetch_add(p, v, __ATOMIC_RELAXED, __HIP_MEMORY_SCOPE_AGENT); }
__device__ __forceinline__ unsigned xb_xcc_id() { return (unsigned)__builtin_amdgcn_s_getreg((3 << 11) | 20) & 0xFu; }
#define XB_SPIN(cond, bar) do { unsigned _sp = 0; while (cond) { __builtin_amdgcn_s_sleep(1); \
    if ((++_sp & 255u) == 0u) { if (xb_ld(&(bar)[XB_TMO])) break; if (_sp > XB_SPIN_CAP) { atomicAdd(&(bar)[XB_TMO], 1u); break; } } } } while (0)
struct XcdBarrier { unsigned* bar; unsigned x; volatile LAS unsigned* st; };
__device__ __forceinline__ XcdBarrier xcd_barrier_post(unsigned* bar, volatile LAS unsigned* st) {
    XcdBarrier b; b.bar = bar; b.x = xb_xcc_id(); b.st = st;
    if (threadIdx.x == 0) (void)xb_add(&bar[XB_XCNT(b.x)], 1u);
    return b;
}
__device__ __forceinline__ void xcd_barrier_complete(unsigned* bar, unsigned x, unsigned& nloc, unsigned& nx) {
    const unsigned G = gridDim.x * gridDim.y * gridDim.z;
    unsigned sum, cnt, mine, sp = 0u;
    for (;;) {
        sum = 0u; cnt = 0u; mine = 0u;
#pragma unroll
        for (unsigned j = 0; j < 16; ++j) { const unsigned c = xb_ld(&bar[XB_XCNT(j)]); sum += c; cnt += (c > 0u) ? 1u : 0u; mine = (j == x) ? c : mine; }
        if (sum == G) break;
        __builtin_amdgcn_s_sleep(1);
        if ((++sp & 255u) == 0u) { if (xb_ld(&bar[XB_TMO])) break; if (sp > XB_SPIN_CAP) { atomicAdd(&bar[XB_TMO], 1u); break; } }
    }
    nloc = mine > 0u ? mine : 1u; nx = cnt > 0u ? cnt : 1u;
}
__device__ __forceinline__ void xcd_barrier(const XcdBarrier& b) {
    asm volatile("s_waitcnt vmcnt(0)" ::: "memory");
    __syncthreads();
    if (threadIdx.x == 0) {
        unsigned* bar = b.bar;
        __builtin_amdgcn_s_waitcnt(0);
        unsigned nloc = b.st[0], nx = b.st[1];
        if (nloc == 0u) { xcd_barrier_complete(bar, b.x, nloc, nx); b.st[0] = nloc; b.st[1] = nx; }
        const unsigned old = xb_add(&bar[XB_XSUB(b.x)], 1u);
        const unsigned gen = old / nloc;
        if (old + 1u == (gen + 1u) * nloc) {
            __builtin_amdgcn_fence(__ATOMIC_RELEASE, "agent");
            asm volatile("s_waitcnt vmcnt(0)" ::: "memory");
            const unsigned og = xb_add(&bar[XB_TOP], 1u);
            const unsigned tg = og / nx;
            if (og + 1u == (tg + 1u) * nx) xb_add(&bar[XB_TOPGEN], 1u);
            else XB_SPIN(xb_ld(&bar[XB_TOPGEN]) == tg, bar);
            __builtin_amdgcn_fence(__ATOMIC_ACQUIRE, "agent");
            xb_add(&bar[XB_XGEN(b.x)], 1u);
            asm volatile("s_waitcnt vmcnt(0)" ::: "memory");
        } else {
            XB_SPIN(xb_ld(&bar[XB_XGEN(b.x)]) == gen, bar);
            __builtin_amdgcn_fence(__ATOMIC_ACQUIRE, "agent");
            asm volatile("s_waitcnt vmcnt(0)" ::: "memory");
        }
    }
    __syncthreads();
}

__device__ __forceinline__ void run_phase(const Frame& F, int ph) {
    if (ph == 0) { phase_pre(F); return; }
    if (ph == NPHASES - 1) { phase_norm1<2>(F); return; }
    const int l = (ph - 1) / 11, s = (ph - 1) % 11;
    switch (s) {
        case 0: if (l == 0) phase_norm1<0>(F); else phase_norm1<1>(F); break;
        case 1: phase_gemm_in(F, l); break;
        case 2: phase_prep(F); break;
        case 3: phase_mix_a(F, l); break;
        case 4: phase_hgrn_b(F); break;
        case 5: phase_hgrn_c(F, l); break;
        case 6: phase_gemm_o(F, l); break;
        case 7: phase_norm2(F, l); break;
        case 8: phase_topk(F, l); break;
        case 9: phase_gemm1(F, l); break;
        default: phase_gemm2(F, l); break;
    }
}

__device__ __forceinline__ void fill_frame(Frame& F, const Args& args, unsigned char* lds) {
    int tid = threadIdx.x; asm volatile("" : "+v"(tid));
    unsigned char* ws = args.ws; asm volatile("" : "+s"(ws));
    F.lds = lds; F.tid = tid; F.lane = tid & 63; F.wave = __builtin_amdgcn_readfirstlane(tid >> 6); F.bid = blockIdx.x; F.G = gridDim.x;
    F.x = args.in[0]; F.c = args.in[1]; F.ctx = args.in[2]; F.c_ctx = args.in[3]; F.ada_w = args.in[4]; F.ada_b = args.in[5]; F.norm1_g = args.in[6]; F.norm2_g = args.in[7];
    F.w_in = args.in[8]; F.attn_sink = args.in[9]; F.hgrn_lb = args.in[10]; F.hgrn_norm_g = args.in[11]; F.conv_w = args.in[12]; F.w_o = args.in[13]; F.router_w = args.in[14];
    F.wg = args.in[15]; F.wu = args.in[16]; F.wd = args.in[17]; F.final_g = args.in[18]; F.out = args.out;
    F.MOD = (float*)(ws + WS_MOD); F.COS = (float*)(ws + WS_COS); F.SIN = (float*)(ws + WS_SIN); F.AFF = (float*)(ws + WS_AFF); F.SLOT = (int*)(ws + WS_SLOT);
    F.ROWMAP = (int*)(ws + WS_ROWMAP); F.GATEV = (float*)(ws + WS_GATEV); F.HD = (float*)(ws + WS_HD); F.HU = (float*)(ws + WS_HU); F.SB = (float*)(ws + WS_SB);
    F.OF = (float*)(ws + WS_OF); F.X = (float*)(ws + WS_X); F.HN = (bf16_t*)(ws + WS_HN); F.PL = (bf16_t*)(ws + WS_PL); F.MIXIN = (bf16_t*)(ws + WS_MIXIN);
    F.HID = (bf16_t*)(ws + WS_HID); F.Y = (bf16_t*)(ws + WS_Y); F.WIN = (bf16_t*)(ws + WS_WIN); F.WO = (bf16_t*)(ws + WS_WO); F.WGU = (bf16_t*)(ws + WS_WGU); F.WD = (bf16_t*)(ws + WS_WD);
}

__global__ void __launch_bounds__(NTHREADS, 2) mk_fwd(Args args) {
    extern __shared__ __attribute__((aligned(16))) unsigned char lds[];
    unsigned char* ws = args.ws;
    const bool multi = args.ph_hi - args.ph_lo > 1;
    XcdBarrier bar; bar.bar = (unsigned*)(ws + WS_CTL); bar.x = 0; bar.st = nullptr;
    volatile LAS unsigned* st = (volatile LAS unsigned*)(LAS unsigned char*)(lds + LDS_BYTES - 16);
    if (multi) {
        if (threadIdx.x == 0) { st[0] = 0u; st[1] = 0u; }
        __syncthreads();
        bar = xcd_barrier_post((unsigned*)(ws + WS_CTL), st);
    }
    for (int ph = args.ph_lo; ph < args.ph_hi; ++ph) {
        Frame F; fill_frame(F, args, lds);
        run_phase(F, ph);
        if (ph + 1 < args.ph_hi) xcd_barrier(bar);
    }
}
}

extern "C" void kernel_launch(void* const* d_in, const int* in_sizes, int n_in, void* d_out, int out_size, void* d_ws, size_t ws_size, hipStream_t stream) {
    static int grid = 0;
    if (grid == 0) {
        if (n_in != 19 || in_sizes[0] != NLAT * D || out_size != NLAT * D || ws_size < WS_END) {
            fprintf(stderr, "kernel_launch: unexpected shapes: n_in %d in0 %d out %d ws %zu (need %zu)\n", n_in, n_in > 0 ? in_sizes[0] : -1, out_size, ws_size, (size_t)WS_END); grid = -1; return; }
        int dev = 0, cus = 0, per_cu = 0;
        if (hipGetDevice(&dev) != hipSuccess || hipDeviceGetAttribute(&cus, hipDeviceAttributeMultiprocessorCount, dev) != hipSuccess) { grid = -1; return; }
        if (hipFuncSetAttribute((const void*)mk_fwd, hipFuncAttributeMaxDynamicSharedMemorySize, LDS_BYTES) != hipSuccess) { fprintf(stderr, "kernel_launch: hipFuncSetAttribute failed\n"); grid = -1; return; }
        if (hipOccupancyMaxActiveBlocksPerMultiprocessor(&per_cu, (const void*)mk_fwd, NTHREADS, LDS_BYTES) != hipSuccess || per_cu < 1) { fprintf(stderr, "kernel_launch: occupancy query says %d\n", per_cu); per_cu = 1; }
        (void)hipGetLastError();
        grid = cus;
    }
    if (grid < 0) return;
    (void)hipMemsetAsync((char*)d_ws + WS_CTL, 0, CTL_BYTES, stream);
    Args a{};
    for (int i = 0; i < 19; ++i) a.in[i] = (const float*)d_in[i];
    a.out = (float*)d_out; a.ws = (unsigned char*)d_ws;
#if MK_ONE_LAUNCH
    a.ph_lo = 0; a.ph_hi = NPHASES;
    void* params[] = {&a};
    hipError_t le = hipLaunchCooperativeKernel((const void*)mk_fwd, dim3(grid), dim3(NTHREADS), params, LDS_BYTES, stream);
    if (le != hipSuccess) fprintf(stderr, "kernel_launch: cooperative launch failed: %s\n", hipGetErrorName(le));
#else
    for (int ph = 0; ph < NPHASES; ++ph) {
        a.ph_lo = ph; a.ph_hi = ph + 1;
        hipLaunchKernelGGL(mk_fwd, dim3(grid), dim3(NTHREADS), LDS_BYTES, stream, a);
    }
#endif
}
```

```cpp
#include <hip/hip_runtime.h>
#include <cstdio>
#include <cstdint>

#ifndef MK_ONE_LAUNCH
#define MK_ONE_LAUNCH 1
#endif

typedef unsigned short bf16_t;
typedef short bf16x8 __attribute__((ext_vector_type(8)));
typedef float f32x4 __attribute__((ext_vector_type(4)));
typedef unsigned u32x4_t __attribute__((ext_vector_type(4)));
typedef unsigned u32x2_t __attribute__((ext_vector_type(2)));
#define LAS __attribute__((address_space(3)))
#define GAS __attribute__((address_space(1)))

namespace {
constexpr int D = 1024, NB = 4, T = 4096, L = 256, NLAT = NB * T, NCTX = NB * L, NROWS = NLAT + NCTX;
constexpr int INC = 2816;
constexpr int OFF_K = 0, OFF_V = 128, OFF_I = 256, OFF_FF = 512, OFF_FB = 768, OFF_Q = 1024, OFF_HQ = 1536, OFF_G = 1792, OFF_CB = 2048, OFF_CC = 2304, OFF_CH = 2560;
constexpr int NE = 16, DE = 2048, CAP_L = 512, CAP_C = 32, EROWS = 2304;
constexpr int NSC = 68;
constexpr int NMODV = 6 * D;
constexpr int NTHREADS = 512, NWAVES = 8;
constexpr int LDS_BYTES = 144 * 1024;
constexpr int NPHASES = 22;
constexpr int TR_NIT = 2 * 16 * (2 * 16 * 32 + 32 * 16);
#ifndef TR_P0
#define TR_P0 4096
#endif

constexpr size_t al(size_t x) { return (x + 4095) & ~(size_t)4095; }
constexpr size_t WS_CTL = 0;                                   constexpr size_t CTL_BYTES = 65536;
constexpr size_t WS_MOD = WS_CTL + CTL_BYTES;
constexpr size_t WS_COS = al(WS_MOD + (size_t)2 * 5 * NMODV * 4);
constexpr size_t WS_SIN = al(WS_COS + (size_t)T * 32 * 4);
constexpr size_t WS_AFF = al(WS_SIN + (size_t)T * 32 * 4);
constexpr size_t WS_SLOT = al(WS_AFF + (size_t)NROWS * 16 * 4);
constexpr size_t WS_ROWMAP = al(WS_SLOT + (size_t)NROWS * 16 * 4);
constexpr size_t WS_GATEV = al(WS_ROWMAP + (size_t)NE * EROWS * 4);
constexpr size_t WS_HD = al(WS_GATEV + (size_t)NE * EROWS * 4);
constexpr size_t WS_HU = al(WS_HD + (size_t)NB * 2 * NSC * 4 * 64 * 4);
constexpr size_t WS_SB = al(WS_HU + (size_t)NB * 2 * NSC * 4 * 4096 * 4);
constexpr size_t WS_OF = al(WS_SB + (size_t)NB * 2 * NSC * 4 * 4096 * 4);
constexpr size_t WS_X = al(WS_OF + (size_t)NROWS * 256 * 4);
constexpr size_t WS_HN = al(WS_X + (size_t)NROWS * D * 4);
constexpr size_t WS_PL = al(WS_HN + (size_t)NROWS * D * 2);
constexpr size_t WS_MIXIN = al(WS_PL + (size_t)NROWS * INC * 2);
constexpr size_t WS_HID = al(WS_MIXIN + (size_t)NROWS * D * 2);
constexpr size_t WS_Y = al(WS_HID + (size_t)NE * EROWS * DE * 2);
constexpr size_t WS_WIN = al(WS_Y + (size_t)NE * EROWS * D * 2);
constexpr size_t WS_WO = al(WS_WIN + (size_t)2 * INC * D * 2);
constexpr size_t WS_WGU = al(WS_WO + (size_t)2 * D * D * 2);
constexpr size_t WS_WD = al(WS_WGU + (size_t)2 * NE * 2 * DE * D * 2);
constexpr size_t WS_VTL = al(WS_WD + (size_t)2 * NE * D * DE * 2);
constexpr size_t WS_VTC = al(WS_VTL + (size_t)NB * 128 * T * 2);
constexpr size_t WS_MODP = al(WS_VTC + (size_t)NB * 128 * L * 2);
constexpr size_t WS_LBT = al(WS_MODP + (size_t)4 * 2 * 5 * NMODV * 4);
constexpr size_t WS_END = al(WS_LBT + (size_t)2 * 2 * 256 * 4);

struct Args { const float* in[19]; float* out; unsigned char* ws; int ph_lo, ph_hi; };

struct Frame {
    unsigned char* lds;
    int tid, lane, wave, bid, G;
    const float *x, *c, *ctx, *c_ctx, *ada_w, *ada_b, *norm1_g, *norm2_g, *w_in, *attn_sink, *hgrn_lb, *hgrn_norm_g, *conv_w, *w_o, *router_w, *wg, *wu, *wd, *final_g;
    float* out;
    float *LBT, *MODP, *MOD, *COS, *SIN, *AFF, *GATEV, *HD, *OF, *X;
    bf16_t *HU, *SB;
    int *SLOT, *ROWMAP;
    bf16_t *HN, *PL, *MIXIN, *HID, *Y, *WIN, *WO, *WGU, *WD, *XS, *VTL, *VTC;
};

__device__ __forceinline__ float bf2f(bf16_t b) { return __uint_as_float((unsigned)b << 16); }
__device__ __forceinline__ bf16_t f2bf(float f) { unsigned u = __float_as_uint(f); u += 0x7fffu + ((u >> 16) & 1u); return (bf16_t)(u >> 16); }
__device__ __forceinline__ int wave_sum_i(int v) {
    v += __builtin_amdgcn_update_dpp(0, v, 0xB1, 0xf, 0xf, true);
    v += __builtin_amdgcn_update_dpp(0, v, 0x4E, 0xf, 0xf, true);
    v += __builtin_amdgcn_update_dpp(0, v, 0x141, 0xf, 0xf, true);
    v += __builtin_amdgcn_update_dpp(0, v, 0x140, 0xf, 0xf, true);
    v += __builtin_amdgcn_ds_swizzle(v, 0x401f);
    const auto r = __builtin_amdgcn_permlane32_swap((unsigned)v, (unsigned)v, false, false);
    return (int)r[0] + (int)r[1];
}
typedef float f32x2_t __attribute__((ext_vector_type(2)));
typedef __bf16 bf16x2_t __attribute__((ext_vector_type(2)));
__device__ __forceinline__ unsigned cvtpk(float lo, float hi) { f32x2_t v = {lo, hi}; bf16x2_t b = __builtin_convertvector(v, bf16x2_t); return __builtin_bit_cast(unsigned, b); }
__device__ __forceinline__ bf16_t f2bfq(float x) { return (bf16_t)cvtpk(x, x); }
__device__ __forceinline__ unsigned pk2(float lo, float hi) { return cvtpk(lo, hi); }
__device__ __forceinline__ float wave_sum(float v) {
    v += __int_as_float(__builtin_amdgcn_update_dpp(0, __float_as_int(v), 0xB1, 0xf, 0xf, true));
    v += __int_as_float(__builtin_amdgcn_update_dpp(0, __float_as_int(v), 0x4E, 0xf, 0xf, true));
    v += __int_as_float(__builtin_amdgcn_update_dpp(0, __float_as_int(v), 0x141, 0xf, 0xf, true));
    v += __int_as_float(__builtin_amdgcn_update_dpp(0, __float_as_int(v), 0x140, 0xf, 0xf, true));
    v += __int_as_float(__builtin_amdgcn_ds_swizzle(__float_as_int(v), 0x401f));
    const auto r = __builtin_amdgcn_permlane32_swap(__float_as_uint(v), __float_as_uint(v), false, false);
    return __uint_as_float(r[0]) + __uint_as_float(r[1]);
}
__device__ __forceinline__ float sigmoidf_(float x) { return __builtin_amdgcn_rcpf(1.f + __expf(-x)); }
__device__ __forceinline__ float siluf_(float x) { return x * __builtin_amdgcn_rcpf(1.f + __expf(-x)); }
__device__ __forceinline__ void wave_lds_sync() { asm volatile("s_waitcnt lgkmcnt(0)" ::: "memory"); }
__device__ __forceinline__ int modb(int r) { return r < NLAT ? (r >> 12) : 4; }
__device__ __forceinline__ int row_of_pos(int b, int pos) { return pos < L ? NLAT + b * L + pos : b * T + (pos - L); }
__device__ __forceinline__ float lb_val(const Frame& F, int l, int dir, int c) {
    if (l == 0) return 0.f;
    const float a0 = F.hgrn_lb[(0 * 2 + dir) * 256 + c], a1 = F.hgrn_lb[(1 * 2 + dir) * 256 + c];
    return 1.f / (1.f + __expf(a0 - a1));
}

typedef short s16x4 __attribute__((ext_vector_type(4)));
typedef short v4i16_t __attribute__((ext_vector_type(4)));
__device__ __forceinline__ s16x4 lds_tr(LAS unsigned char* p) { return __builtin_bit_cast(s16x4, __builtin_amdgcn_ds_read_tr16_b64_v4i16((LAS v4i16_t*)p)); }
template <class RM>
__device__ __forceinline__ void transpose_item(const float* __restrict__ W, int K, int N, bf16_t* __restrict__ WT, RM rowmap, LAS unsigned char* scr, int item, int lane) {
    const int nblk = N / 64, kb = item / nblk, nb = item % nblk, k0 = 64 * kb, n0 = 64 * nb;
    const int r4 = lane >> 4, q4 = lane & 15;
    const float* src = W + (size_t)(k0 + r4) * N + n0 + q4 * 4;
    f32x4 v[16];
#pragma unroll
    for (int i = 0; i < 16; ++i) v[i] = *(const f32x4*)(src + (size_t)(4 * i) * N);
    wave_lds_sync();
#pragma unroll
    for (int i = 0; i < 16; ++i) *(LAS u32x2_t*)(scr + (4 * i + r4) * 144 + q4 * 8) = (u32x2_t){cvtpk(v[i].x, v[i].y), cvtpk(v[i].z, v[i].w)};
    wave_lds_sync();
    const int trb = (8 * r4 + (q4 >> 2)) * 144 + 8 * (q4 & 3);
#pragma unroll
    for (int c16 = 0; c16 < 4; ++c16) {
        bf16_t* dst = WT + (size_t)rowmap(n0 + 16 * c16 + q4) * K + k0 + 8 * r4;
#pragma unroll
        for (int kh = 0; kh < 2; ++kh) {
            const s16x4 lo = lds_tr(scr + trb + kh * 32 * 144 + c16 * 32), hi = lds_tr(scr + trb + (kh * 32 + 4) * 144 + c16 * 32);
            *(bf16x8*)(dst + 32 * kh) = (bf16x8){lo[0], lo[1], lo[2], lo[3], hi[0], hi[1], hi[2], hi[3]};
        }
    }
}
struct RMId { __device__ __forceinline__ int operator()(int n) const { return n; } };
struct RMIn { __device__ __forceinline__ int operator()(int n) const { const int c = n & 31; return (n < 128 || (n >= OFF_Q && n < OFF_HQ)) ? n : (n & ~31) + 16 * ((c >> 2) & 1) + 4 * (c >> 3) + (c & 3); } };
struct RMGate { __device__ __forceinline__ int operator()(int n) const { return (n >> 7) * 256 + (n & 127); } };
struct RMUp { __device__ __forceinline__ int operator()(int n) const { return (n >> 7) * 256 + 128 + (n & 127); } };

__device__ __forceinline__ void phase_pre(const Frame& F) {
    float* s_l = (float*)F.lds;
    float* red = s_l + 5 * 1024;
    for (int i = F.tid; i < 5 * 1024; i += NTHREADS) { const int b = i >> 10, k = i & 1023; const float c = b < 4 ? F.c[b * 1024 + k] : F.c_ctx[k]; s_l[i] = c / (1.f + __expf(-c)); }
    __syncthreads();
    for (int item = F.bid; item < 768; item += F.G) {
        const int kq4 = item & 3, ng = item >> 2, l = ng / 96, n0 = (ng % 96) * 64, kq = F.tid >> 6, n = F.tid & 63;
        float acc[5] = {0.f, 0.f, 0.f, 0.f, 0.f};
        const int kb = kq4 * 256 + kq * 32;
        const float* W = F.ada_w + (size_t)l * D * NMODV + (size_t)kb * NMODV + n0 + n;
#pragma unroll 8
        for (int kk = 0; kk < 32; ++kk) { const float w = W[(size_t)kk * NMODV];
#pragma unroll
            for (int b = 0; b < 5; ++b) acc[b] += s_l[b * 1024 + kb + kk] * w; }
#pragma unroll
        for (int b = 0; b < 5; ++b) red[(kq * 5 + b) * 64 + n] = acc[b];
        __syncthreads();
        if (F.tid < 320) { const int b = F.tid >> 6; float s = 0.f;
#pragma unroll
            for (int q = 0; q < 8; ++q) s += red[(q * 5 + b) * 64 + n];
            if (kq4 == 0) s += F.ada_b[l * NMODV + n0 + n];
            F.MODP[(size_t)kq4 * (2 * 5 * NMODV) + (size_t)(l * 5 + b) * NMODV + n0 + n] = s; }
        __syncthreads();
    }
    for (int i = F.bid * NTHREADS + F.tid; i < 2 * 2 * 256; i += F.G * NTHREADS) { const int ll = i >> 9, dc = i & 511; F.LBT[i] = lb_val(F, ll, dc >> 8, dc & 255); }
    for (int i = F.bid * NTHREADS + F.tid; i < T * 32; i += F.G * NTHREADS) {
        const int t = i >> 5, a = (i >> 4) & 1, f = i & 15; const float pos = (float)(a == 0 ? (t >> 6) : (t & 63));
        const float inv = __builtin_amdgcn_exp2f(-(float)f * (13.287712379549449f / 16.f)); const float ang = pos * inv;
        F.COS[i] = __cosf(ang); F.SIN[i] = __sinf(ang);
    }
    LAS unsigned char* scr = (LAS unsigned char*)F.lds + F.wave * (64 * 144);
    __syncthreads();
    constexpr int I_IN = 16 * 44, I_O = 16 * 16;
    const int gw = F.bid * NWAVES + F.wave, NGW = F.G * NWAVES;
    for (int it = gw; it < 2 * (I_IN + I_O); it += NGW) {
        const int l = it / (I_IN + I_O); const int r = it % (I_IN + I_O);
        if (r < I_IN) transpose_item(F.w_in + (size_t)l * D * INC, D, INC, F.WIN + (size_t)l * INC * D, RMIn(), scr, r, F.lane);
        else transpose_item(F.w_o + (size_t)l * D * D, D, D, F.WO + (size_t)l * D * D, RMId(), scr, r - I_IN, F.lane);
    }
}
struct TrDesc { const float* src; bf16_t* WT; int K, N, kind, k0, n0; };
__device__ __forceinline__ TrDesc tr_decode(const Frame& F, int it, int lane) {
    constexpr int I_G = 16 * 32, I_D = 32 * 16, PER_E = 2 * I_G + I_D;
    TrDesc d; const size_t le = (size_t)(it / PER_E); int r = it % PER_E; const float* W;
    if (r < I_G) { W = F.wg + le * D * DE; d.WT = F.WGU + le * 2 * DE * D; d.K = D; d.N = DE; d.kind = 1; }
    else if (r < 2 * I_G) { r -= I_G; W = F.wu + le * D * DE; d.WT = F.WGU + le * 2 * DE * D; d.K = D; d.N = DE; d.kind = 2; }
    else { r -= 2 * I_G; W = F.wd + le * DE * D; d.WT = F.WD + le * D * DE; d.K = DE; d.N = D; d.kind = 0; }
    const int nblk = d.N / 64; d.k0 = 64 * (r / nblk); d.n0 = 64 * (r % nblk);
    d.src = W + (size_t)(d.k0 + (lane >> 4)) * d.N + d.n0 + (lane & 15) * 4;
    return d;
}
#define TR_LOAD(DSC, V) do { _Pragma("unroll") for (int i_ = 0; i_ < 16; ++i_) V[i_] = *(const f32x4*)((DSC).src + (size_t)(4 * i_) * (DSC).N); } while (0)
__device__ __forceinline__ void tr_store(const TrDesc& d, const f32x4 (&v)[16], LAS unsigned char* scr, int lane) {
    const int r4 = lane >> 4, q4 = lane & 15;
    wave_lds_sync();
#pragma unroll
    for (int i = 0; i < 16; ++i) *(LAS u32x2_t*)(scr + (4 * i + r4) * 144 + q4 * 8) = (u32x2_t){cvtpk(v[i].x, v[i].y), cvtpk(v[i].z, v[i].w)};
    wave_lds_sync();
    const int trb = (8 * r4 + (q4 >> 2)) * 144 + 8 * (q4 & 3);
#pragma unroll
    for (int c16 = 0; c16 < 4; ++c16) {
        const int n0_ = d.n0 + 16 * c16 + q4; const int c_ = n0_ & 31; const int n = (n0_ & ~31) + 16 * ((c_ >> 2) & 1) + 4 * (c_ >> 3) + (c_ & 3);
        const int row = d.kind == 0 ? n : (n >> 7) * 256 + (d.kind == 2 ? 128 : 0) + (n & 127);
        bf16_t* dst = d.WT + (size_t)row * d.K + d.k0 + 8 * r4;
#pragma unroll
        for (int kh = 0; kh < 2; ++kh) {
            const s16x4 lo = lds_tr(scr + trb + kh * 32 * 144 + c16 * 32), hi = lds_tr(scr + trb + (kh * 32 + 4) * 144 + c16 * 32);
            *(bf16x8*)(dst + 32 * kh) = (bf16x8){lo[0], lo[1], lo[2], lo[3], hi[0], hi[1], hi[2], hi[3]};
        }
    }
}
__device__ __forceinline__ void phase_transposer(const Frame& F, int widx, int nw, int first, int last) {
    LAS unsigned char* scr = (LAS unsigned char*)F.lds + F.wave * (64 * 144);
    const int NIT = last;
    f32x4 va[16], vb[16];
    int it = first + widx;
    if (it >= NIT) return;
    TrDesc da = tr_decode(F, it, F.lane), db = da;
    TR_LOAD(da, va);
    for (;;) {
        const bool hb = it + nw < NIT;
        if (hb) { db = tr_decode(F, it + nw, F.lane); TR_LOAD(db, vb); }
        tr_store(da, va, scr, F.lane);
        if (!hb) break;
        it += nw;
        const bool ha = it + nw < NIT;
        if (ha) { da = tr_decode(F, it + nw, F.lane); TR_LOAD(da, va); }
        tr_store(db, vb, scr, F.lane);
        if (!ha) break;
        it += nw;
    }
}
constexpr int TRQ_WORD = 15000, TRQ_CHUNK = 4;
struct TrQ { unsigned* q; int first, last, cur, end, nbase; };
__device__ __forceinline__ int trq_fetch(const TrQ& Q, int lane) { unsigned v = 0u; if (lane == 0) v = __hip_atomic_fetch_add(Q.q, (unsigned)TRQ_CHUNK, __ATOMIC_RELAXED, __HIP_MEMORY_SCOPE_AGENT); return Q.first + (int)__builtin_amdgcn_readfirstlane(v); }
__device__ __forceinline__ int trq_next(TrQ& Q, int lane) {
    if (Q.cur < Q.end) return Q.cur++;
    const int b = Q.nbase; if (b >= Q.last) return -1;
    Q.cur = b + 1; Q.end = b + TRQ_CHUNK < Q.last ? b + TRQ_CHUNK : Q.last; Q.nbase = trq_fetch(Q, lane);
    return b;
}
__device__ __forceinline__ void phase_transposer_dyn(const Frame& F, unsigned* q, int first, int last) {
    LAS unsigned char* scr = (LAS unsigned char*)F.lds + F.wave * (64 * 144);
    TrQ Q; Q.q = q; Q.first = first; Q.last = last; Q.cur = 0; Q.end = 0; Q.nbase = trq_fetch(Q, F.lane);
    f32x4 va[16], vb[16];
    int it = trq_next(Q, F.lane);
    if (it < 0) return;
    TrDesc da = tr_decode(F, it, F.lane), db = da;
    TR_LOAD(da, va);
    for (;;) {
        const int itb = trq_next(Q, F.lane); const bool hb = itb >= 0;
        if (hb) { db = tr_decode(F, itb, F.lane); TR_LOAD(db, vb); }
        tr_store(da, va, scr, F.lane);
        if (!hb) break;
        const int ita = trq_next(Q, F.lane); const bool ha = ita >= 0;
        if (ha) { da = tr_decode(F, ita, F.lane); TR_LOAD(da, va); }
        tr_store(db, vb, scr, F.lane);
        if (!ha) break;
    }
}
#undef TR_LOAD

template <int MODE>
__device__ __forceinline__ void phase_norm1(const Frame& F) {
    const int gw = F.bid * NWAVES + F.wave, NGW = F.G * NWAVES, lane = F.lane;
    const int nrows = MODE == 2 ? NLAT : NROWS;
    const int lprev = MODE == 1 ? 0 : 1;
    const int lcur = MODE == 0 ? 0 : 1;
    if (MODE == 0) {
        for (int i = F.bid * NTHREADS + F.tid; i < 2 * 5 * NMODV / 4; i += F.G * NTHREADS) {
            const f32x4* p = (const f32x4*)F.MODP + i; constexpr int Q = 2 * 5 * NMODV / 4;
            ((f32x4*)F.MOD)[i] = ((p[0] + p[Q]) + p[2 * Q]) + p[3 * Q];
        }
    }
    for (int r = gw; r < nrows; r += NGW) {
        const int mb = modb(r);
        f32x4 v[4];
        const float* src = MODE == 0 ? (r < NLAT ? F.x + (size_t)r * D : F.ctx + (size_t)(r - NLAT) * D) : F.X + (size_t)r * D;
#pragma unroll
        for (int j = 0; j < 4; ++j) v[j] = *(const f32x4*)(src + lane * 4 + 256 * j);
        if (MODE != 0) {
            f32x4 acc[4];
#pragma unroll
            for (int j = 0; j < 4; ++j) acc[j] = (f32x4){0.f, 0.f, 0.f, 0.f};
            int sl = -1; float gl = 0.f;
            if (lane < NE) { sl = F.SLOT[(size_t)r * 16 + lane]; if (sl >= 0) gl = F.GATEV[lane * EROWS + sl]; }
            unsigned mk = (unsigned)__ballot(sl >= 0);
            if (MODE == 1 && r >= NLAT) {
                const bf16_t* YPb = (const bf16_t*)F.OF;
                while (mk) {
                    const int e0 = __builtin_ctz(mk); mk &= mk - 1u;
                    const int s0 = __builtin_amdgcn_readlane(sl, e0); const float g0 = __int_as_float(__builtin_amdgcn_readlane(__float_as_int(gl), e0));
                    const bf16_t* y0 = YPb + ((size_t)e0 * 128 + (s0 - 4 * CAP_L)) * D; constexpr size_t QS = (size_t)NE * 128 * D;
                    uint2 w0[4], w1[4], w2[4], w3[4];
#pragma unroll
                    for (int j = 0; j < 4; ++j) { w0[j] = *(const uint2*)(y0 + lane * 4 + 256 * j); w1[j] = *(const uint2*)(y0 + QS + lane * 4 + 256 * j); w2[j] = *(const uint2*)(y0 + 2 * QS + lane * 4 + 256 * j); w3[j] = *(const uint2*)(y0 + 3 * QS + lane * 4 + 256 * j); }
#pragma unroll
                    for (int j = 0; j < 4; ++j) {
                        acc[j].x += g0 * (((__uint_as_float(w0[j].x << 16) + __uint_as_float(w1[j].x << 16)) + __uint_as_float(w2[j].x << 16)) + __uint_as_float(w3[j].x << 16));
                        acc[j].y += g0 * (((__uint_as_float(w0[j].x & 0xffff0000u) + __uint_as_float(w1[j].x & 0xffff0000u)) + __uint_as_float(w2[j].x & 0xffff0000u)) + __uint_as_float(w3[j].x & 0xffff0000u));
                        acc[j].z += g0 * (((__uint_as_float(w0[j].y << 16) + __uint_as_float(w1[j].y << 16)) + __uint_as_float(w2[j].y << 16)) + __uint_as_float(w3[j].y << 16));
                        acc[j].w += g0 * (((__uint_as_float(w0[j].y & 0xffff0000u) + __uint_as_float(w1[j].y & 0xffff0000u)) + __uint_as_float(w2[j].y & 0xffff0000u)) + __uint_as_float(w3[j].y & 0xffff0000u));
                    }
                }
            }
            while (mk) {
                const int e0 = __builtin_ctz(mk); mk &= mk - 1u;
                const bool two = mk != 0u; const int e1 = two ? __builtin_ctz(mk) : e0; if (two) mk &= mk - 1u;
                const int s0 = __builtin_amdgcn_readlane(sl, e0), s1 = __builtin_amdgcn_readlane(sl, e1);
                const float g0 = __int_as_float(__builtin_amdgcn_readlane(__float_as_int(gl), e0)), g1 = two ? __int_as_float(__builtin_amdgcn_readlane(__float_as_int(gl), e1)) : 0.f;
                const bf16_t* y0 = F.Y + ((size_t)e0 * EROWS + s0) * D; const bf16_t* y1 = F.Y + ((size_t)e1 * EROWS + s1) * D;
                uint2 w0[4], w1[4];
#pragma unroll
                for (int j = 0; j < 4; ++j) { w0[j] = *(const uint2*)(y0 + lane * 4 + 256 * j); w1[j] = *(const uint2*)(y1 + lane * 4 + 256 * j); }
#pragma unroll
                for (int j = 0; j < 4; ++j) {
                    acc[j].x += g0 * __uint_as_float(w0[j].x << 16); acc[j].y += g0 * __uint_as_float(w0[j].x & 0xffff0000u);
                    acc[j].z += g0 * __uint_as_float(w0[j].y << 16); acc[j].w += g0 * __uint_as_float(w0[j].y & 0xffff0000u);
                    acc[j].x += g1 * __uint_as_float(w1[j].x << 16); acc[j].y += g1 * __uint_as_float(w1[j].x & 0xffff0000u);
                    acc[j].z += g1 * __uint_as_float(w1[j].y << 16); acc[j].w += g1 * __uint_as_float(w1[j].y & 0xffff0000u);
                }
            }
            const float* g2 = F.MOD + (size_t)(lprev * 5 + mb) * NMODV + 5 * D;
#pragma unroll
            for (int j = 0; j < 4; ++j) { const f32x4 gg = *(const f32x4*)(g2 + lane * 4 + 256 * j); v[j] += gg * acc[j]; }
        }
        if (MODE == 1) {
#pragma unroll
            for (int j = 0; j < 4; ++j) *(f32x4*)(F.X + (size_t)r * D + lane * 4 + 256 * j) = v[j];
        }
        float ss = 0.f;
#pragma unroll
        for (int j = 0; j < 4; ++j) ss += (v[j].x * v[j].x + v[j].y * v[j].y) + (v[j].z * v[j].z + v[j].w * v[j].w);
        ss = wave_sum(ss);
        const float rstd = rsqrtf(ss * (1.f / D) + 1e-6f);
        if (MODE == 2) {
#pragma unroll
            for (int j = 0; j < 4; ++j) { const f32x4 g = *(const f32x4*)(F.final_g + lane * 4 + 256 * j); *(f32x4*)(F.out + (size_t)r * D + lane * 4 + 256 * j) = v[j] * rstd * g; }
        } else {
            const float* mv = F.MOD + (size_t)(lcur * 5 + mb) * NMODV;
#pragma unroll
            for (int j = 0; j < 4; ++j) {
                const int c0 = lane * 4 + 256 * j;
                const f32x4 g = *(const f32x4*)(F.norm1_g + lcur * D + c0);
                f32x4 sh, sc;
                if (MODE == 0) { const float* pp = F.MODP + (size_t)mb * NMODV + c0; constexpr int Q = 2 * 5 * NMODV;
                    sh = ((*(const f32x4*)pp + *(const f32x4*)(pp + Q)) + *(const f32x4*)(pp + 2 * Q)) + *(const f32x4*)(pp + 3 * Q);
                    sc = ((*(const f32x4*)(pp + D) + *(const f32x4*)(pp + D + Q)) + *(const f32x4*)(pp + D + 2 * Q)) + *(const f32x4*)(pp + D + 3 * Q); }
                else { sh = *(const f32x4*)(mv + c0); sc = *(const f32x4*)(mv + D + c0); }
                const f32x4 h = v[j] * rstd * g * (sc + 1.f) + sh;
                uint2 w; w.x = pk2(h.x, h.y); w.y = pk2(h.z, h.w);
                *(uint2*)(F.HN + (size_t)r * D + c0) = w;
            }
        }
    }
}

namespace pg8 {
typedef unsigned u32x4 __attribute__((ext_vector_type(4)));
constexpr int BM = 256, BK = 64, HALF = 128, HTB = HALF * BK * 2, STAGE_BYTES = 8 * HTB, NXCD = 8;
__device__ __forceinline__ int lds_byte(int r, int c) { const int st = (r >> 4) * 2 + (c >> 5), rr = r & 15, cc = c & 31, ob = rr * 64 + cc * 2; return st * 1024 + (ob ^ (((ob >> 9) & 1) << 5)); }
__device__ __forceinline__ void stage_rc(int b, int& R, int& C) { const int st = b / 1024, sb = b % 1024, swz = sb ^ (((sb >> 9) & 1) << 5); R = (st >> 1) * 16 + swz / 64; C = (st & 1) * 32 + (swz % 64) / 2; }
struct Unit { const char* a; const char* b; int pm, pn, e, half, nt; };
struct TileOrder {
    int nM, nN, nwg, G, c, WGM;
    __device__ __forceinline__ void init(int nM_, int nN_, int WGM_, int G_, int c_) { nM = nM_; nN = nN_; nwg = nM * nN; G = G_; c = c_; WGM = WGM_; }
    __device__ __forceinline__ bool decode(int i, int& pm, int& pn) const {
        const long Lx = (long)i * G + c; if (Lx >= nwg) return false;
        int wgid = (int)Lx; { const int q = nwg / NXCD, r = nwg % NXCD, xcd = wgid % NXCD, off = wgid / NXCD; wgid = (xcd < r ? xcd * (q + 1) : r * (q + 1) + (xcd - r) * q) + off; }
        const int nig = WGM * nN, gid = wgid / nig, fm = gid * WGM, gsz = (nM - fm) < WGM ? (nM - fm) : WGM;
        pm = fm + ((wgid % nig) % gsz); pn = (wgid % nig) / gsz; return true;
    }
};
template <class Epi, class Sched, bool ALIGN_EPI>
__device__ __forceinline__ void gemm_phase(LAS unsigned char* lds, const int tid, const int K, const Sched& S, const Epi& E) {
    const int wid = __builtin_amdgcn_readfirstlane(tid >> 6), lane = tid & 63, wr = wid >> 2, wc = wid & 3, fr = lane & 15, fq = lane >> 4;
    unsigned voffA[2];
#pragma unroll
    for (int i = 0; i < 2; ++i) { int R, C; stage_rc(tid * 16 + i * 8192, R, C); voffA[i] = (unsigned)(R * K + C) * 2u; }
    const size_t kstep = (size_t)(BK * 2);
    const size_t hstep = (size_t)HALF * K * 2;
    const unsigned ldsw = (unsigned)wid * 1024u;
    const int aoff = lds_byte(wr * 64 + fr, fq * 8), boff = lds_byte(wc * 32 + fr, fq * 8);
#define PG8_SA(b, h) (((b) * 2 + (h)) * HTB)
#define PG8_SB(b, h) ((4 + (b) * 2 + (h)) * HTB)
#define PG8_STAGE(bufoff, gbase) do { _Pragma("unroll") for (int _i = 0; _i < 2; ++_i) \
        __builtin_amdgcn_global_load_lds((const unsigned*)((const char*)(gbase) + voffA[_i]), (LAS unsigned*)(lds + (bufoff) + ldsw + _i * 8192), 16, 0, 0); } while (0)
#define PG8_LDA(dst, b, h) do { _Pragma("unroll") for (int m = 0; m < 4; ++m) _Pragma("unroll") for (int k = 0; k < 2; ++k) dst[m][k] = *(const LAS bf16x8*)(lds + PG8_SA(b, h) + aoff + m * 2048 + k * 1024); } while (0)
#define PG8_LDB(dst, b, h) do { _Pragma("unroll") for (int n = 0; n < 2; ++n) _Pragma("unroll") for (int k = 0; k < 2; ++k) dst[n][k] = *(const LAS bf16x8*)(lds + PG8_SB(b, h) + boff + n * 2048 + k * 1024); } while (0)
#define PG8_MMA(ai, bj, At, Bt) do { __builtin_amdgcn_s_setprio(1); _Pragma("unroll") for (int m = 0; m < 4; ++m) _Pragma("unroll") for (int n = 0; n < 2; ++n) _Pragma("unroll") for (int k = 0; k < 2; ++k) \
        acc[ai][bj][m][n] = __builtin_amdgcn_mfma_f32_16x16x32_bf16(Bt[n][k], At[m][k], acc[ai][bj][m][n], 0, 0, 0); __builtin_amdgcn_s_setprio(0); } while (0)
#define PG8_WAIT_V(n) asm volatile("s_waitcnt vmcnt(" #n ")" ::: "memory")
#define PG8_WAIT_L(n) asm volatile("s_waitcnt lgkmcnt(" #n ")" ::: "memory")
#define PG8_BAR __builtin_amdgcn_s_barrier()
#define PG8_SCHED __builtin_amdgcn_sched_barrier(0)
    Unit cur, nxt; int ui = 0;
    if (!S.next(0, cur)) return;
    f32x4 acc[2][2][4][2];
#pragma unroll
    for (int a = 0; a < 2; ++a)
#pragma unroll
        for (int b = 0; b < 2; ++b)
#pragma unroll
            for (int m = 0; m < 4; ++m)
#pragma unroll
                for (int n = 0; n < 2; ++n) acc[a][b][m][n] = (f32x4){0.f, 0.f, 0.f, 0.f};
    bf16x8 At[4][2], B0[2][2], B1[2][2];
    const char* cA = cur.a; const char* cB = cur.b;
    PG8_STAGE(PG8_SB(0, 0), cB); PG8_STAGE(PG8_SB(0, 1), cB + hstep); PG8_STAGE(PG8_SA(0, 0), cA); PG8_STAGE(PG8_SA(0, 1), cA + hstep);
    PG8_STAGE(PG8_SB(1, 0), cB + kstep); PG8_STAGE(PG8_SA(1, 0), cA + kstep); PG8_STAGE(PG8_SB(1, 1), cB + hstep + kstep); PG8_STAGE(PG8_SA(1, 1), cA + hstep + kstep);
    PG8_WAIT_V(0); PG8_BAR;
    if (wr == 1) PG8_BAR;
    for (;;) {
        const bool has_next = S.next(ui + 1, nxt);
        const char* nA = has_next ? nxt.a : cA; const char* nB = has_next ? nxt.b : cB;
        const int nt = cur.nt;
        for (int t = 0; t < nt; t += 2) {
            const bool last = (t == nt - 2);
            const char* a1 = cA + (size_t)(t + 1) * kstep;
            const char* a2 = last ? nA : cA + (size_t)(t + 2) * kstep; const char* b2 = last ? nB : cB + (size_t)(t + 2) * kstep;
            const char* a3 = a2 + kstep; const char* b3 = b2 + kstep;
            PG8_LDB(B0, 0, 0); PG8_LDB(B1, 0, 1); PG8_SCHED; PG8_LDA(At, 0, 0); if (t != 0) { PG8_STAGE(PG8_SA(1, 1), a1 + hstep);
            PG8_WAIT_V(8); } PG8_WAIT_L(0); PG8_BAR; PG8_MMA(0, 0, At, B0); PG8_MMA(0, 1, At, B1); PG8_BAR; PG8_SCHED;
            PG8_LDA(At, 0, 1); PG8_STAGE(PG8_SB(0, 0), b2); PG8_STAGE(PG8_SB(0, 1), b2 + hstep); PG8_STAGE(PG8_SA(0, 0), a2);
            if (t != 0) PG8_WAIT_V(8); PG8_WAIT_L(0); PG8_BAR; if (!cur.half) { PG8_MMA(1, 0, At, B0); PG8_MMA(1, 1, At, B1); } PG8_BAR; PG8_SCHED;
            PG8_LDB(B0, 1, 0); PG8_LDB(B1, 1, 1); PG8_SCHED; PG8_LDA(At, 1, 0); PG8_STAGE(PG8_SA(0, 1), a2 + hstep);
            if (t != 0) PG8_WAIT_V(8); PG8_WAIT_L(0); PG8_BAR; PG8_MMA(0, 0, At, B0); PG8_MMA(0, 1, At, B1); PG8_BAR; PG8_SCHED;
            PG8_LDA(At, 1, 1); PG8_STAGE(PG8_SB(1, 0), b3); PG8_STAGE(PG8_SB(1, 1), b3 + hstep); PG8_STAGE(PG8_SA(1, 0), a3);
            PG8_WAIT_V(8); PG8_WAIT_L(0); PG8_BAR; if (!cur.half) { PG8_MMA(1, 0, At, B0); PG8_MMA(1, 1, At, B1); } PG8_BAR; PG8_SCHED;
        }
        if constexpr (ALIGN_EPI) { if (wr == 0) PG8_BAR; }
        PG8_STAGE(PG8_SA(1, 1), nA + kstep + hstep);
        E.pre(acc, cur, wr, wc, fr, fq);
        PG8_WAIT_V(0);
        E.st(acc, cur, wr, wc, fr, fq);
        if (!has_next) break;
#pragma unroll
        for (int a = 0; a < 2; ++a)
#pragma unroll
            for (int b = 0; b < 2; ++b)
#pragma unroll
                for (int m = 0; m < 4; ++m)
#pragma unroll
                    for (int n = 0; n < 2; ++n) acc[a][b][m][n] = (f32x4){0.f, 0.f, 0.f, 0.f};
        cur = nxt; cA = nA; cB = nB; ++ui;
        if constexpr (ALIGN_EPI) { if (wr == 1) PG8_BAR; }
    }
    PG8_WAIT_V(0);
    if constexpr (!ALIGN_EPI) { if (wr == 0) PG8_BAR; }
    PG8_BAR;
#undef PG8_SA
#undef PG8_SB
#undef PG8_STAGE
#undef PG8_LDA
#undef PG8_LDB
#undef PG8_MMA
#undef PG8_WAIT_V
#undef PG8_WAIT_L
#undef PG8_BAR
#undef PG8_SCHED
}
}

typedef f32x4 acc_t[2][2][4][2];
__device__ __forceinline__ uint2 pk4(const f32x4 v) { uint2 w; w.x = pk2(v.x, v.y); w.y = pk2(v.z, v.w); return w; }

struct SchedIn { pg8::TileOrder o; const char* A; const char* B;
    __device__ __forceinline__ bool next(int i, pg8::Unit& u) const { int pm, pn; if (!o.decode(i, pm, pn)) return false; u.pm = pm; u.pn = pn; u.e = 0; u.half = 0; u.nt = D / 64; u.a = A + (size_t)pm * 256 * D * 2; u.b = B + (size_t)pn * 256 * D * 2; return true; } };
struct EpiPL { bf16_t* PL; const float* COS; const float* SIN; bf16_t* VTL; bf16_t* VTC; const float* LBTl;
    __device__ __forceinline__ void pre(acc_t& acc, const pg8::Unit& u, int wr, int wc, int fr, int fq) const {}
    __device__ __forceinline__ void st(const acc_t& acc, const pg8::Unit& u, int wr, int wc, int fr, int fq) const {
        const bool qcols = (u.pn == 4 || u.pn == 5), anyid = qcols || u.pn == 0;
#pragma unroll
        for (int ai = 0; ai < 2; ++ai)
#pragma unroll
            for (int m = 0; m < 4; ++m) {
                const int row = u.pm * 256 + ai * 128 + wr * 64 + m * 16 + fr; const bool lat = row < NLAT; const int t = row & (T - 1);
                f32x4 cs = (f32x4){1.f, 1.f, 1.f, 1.f}, sn = (f32x4){0.f, 0.f, 0.f, 0.f};
                if (anyid && lat) { cs = *(const f32x4*)(COS + t * 32 + (wc & 1) * 16 + 4 * fq); sn = *(const f32x4*)(SIN + t * 32 + (wc & 1) * 16 + 4 * fq); }
#pragma unroll
                for (int bj = 0; bj < 2; ++bj) {
                    const bool ident = qcols || (u.pn == 0 && bj == 0);
                    f32x4 x1 = acc[ai][bj][m][0], x2 = acc[ai][bj][m][1];
                    bf16_t* pb = PL + (size_t)row * INC + u.pn * 256 + bj * 128 + wc * 32;
                    if (ident) {
                        if (lat) { const f32x4 y1 = x1 * cs - x2 * sn, y2 = x2 * cs + x1 * sn; x1 = y1; x2 = y2; }
                        const uint2 w1 = pk4(x1), w2 = pk4(x2);
                        *(u32x4_t*)(pb + 8 * fq) = (u32x4_t){w1.x, w1.y, w2.x, w2.y};
                    } else {
                        if (u.pn == 2 || u.pn == 3) {
                            const float* lbp = LBTl + (u.pn - 2) * 256 + bj * 128 + wc * 32 + 8 * fq; const f32x4 l1 = *(const f32x4*)lbp, l2 = *(const f32x4*)(lbp + 4);
#pragma unroll
                            for (int i = 0; i < 4; ++i) { x1[i] = fmaxf(__logf(1.f - (1.f - l1[i]) * sigmoidf_(-x1[i])), -69.f); x2[i] = fmaxf(__logf(1.f - (1.f - l2[i]) * sigmoidf_(-x2[i])), -69.f); }
                        }
                        if (u.pn == 6 || u.pn == 7) {
#pragma unroll
                            for (int i = 0; i < 4; ++i) { x1[i] = siluf_(x1[i]); x2[i] = siluf_(x2[i]); }
                        }
                        const uint2 w1 = pk4(x1), w2 = pk4(x2);
                        *(u32x4_t*)(pb + 8 * fq) = (u32x4_t){w1.x, w1.y, w2.x, w2.y};
                    }
                }
            }
    } };
__device__ __forceinline__ void phase_gemm_in(const Frame& F, int l) {
    SchedIn S; S.o.init(NROWS / 256, INC / 256, 8, F.G, F.bid); S.A = (const char*)F.HN; S.B = (const char*)(F.WIN + (size_t)l * INC * D);
    EpiPL E{F.PL, F.COS, F.SIN, F.VTL, F.VTC, F.LBT + l * 512};
    pg8::gemm_phase<EpiPL, SchedIn, true>((LAS unsigned char*)F.lds, F.tid, D, S, E);
}
struct EpiO { float* X; const float* MODg; const float* xin; const float* cin;
    __device__ __forceinline__ void pre(acc_t& acc, const pg8::Unit& u, int wr, int wc, int fr, int fq) const {}
    __device__ __forceinline__ void st(const acc_t& acc, const pg8::Unit& u, int wr, int wc, int fr, int fq) const {
#pragma unroll
        for (int ai = 0; ai < 2; ++ai)
#pragma unroll
            for (int m = 0; m < 4; ++m) {
                const int row = u.pm * 256 + ai * 128 + wr * 64 + m * 16 + fr; const float* gp = MODg + (size_t)modb(row) * NMODV;
                const float* bp = xin ? (row < NLAT ? xin + (size_t)row * D : cin + (size_t)(row - NLAT) * D) : X + (size_t)row * D;
#pragma unroll
                for (int bj = 0; bj < 2; ++bj)
#pragma unroll
                    for (int n = 0; n < 2; ++n) { const int col = u.pn * 256 + bj * 128 + wc * 32 + 16 * n + 4 * fq; const f32x4 g = *(const f32x4*)(gp + col); *(f32x4*)(X + (size_t)row * D + col) = *(const f32x4*)(bp + col) + g * acc[ai][bj][m][n]; }
            }
    } };
__device__ __forceinline__ void phase_gemm_o(const Frame& F, int l) {
    SchedIn S; S.o.init((l == 0 ? NROWS : NLAT) / 256, D / 256, 8, F.G, F.bid); S.A = (const char*)F.MIXIN; S.B = (const char*)(F.WO + (size_t)l * D * D);
    EpiO E{F.X, F.MOD + (size_t)l * 5 * NMODV + 2 * D, l == 0 ? F.x : nullptr, F.ctx};
    pg8::gemm_phase<EpiO, SchedIn, true>((LAS unsigned char*)F.lds, F.tid, D, S, E);
}
struct SchedG { pg8::TileOrder o; const char* A; const char* B; int RT, nt; size_t a_estride, b_estride, tbytes;
    __device__ __forceinline__ bool next(int i, pg8::Unit& u) const { int pm, pn; if (!o.decode(i, pm, pn)) return false; const int e = pm / RT, rt = pm - e * RT; u.pm = rt; u.pn = pn; u.e = e; u.half = (rt == 8) ? 1 : 0; u.nt = nt;
        u.a = A + (size_t)e * a_estride + (size_t)rt * tbytes; u.b = B + (size_t)e * b_estride + (size_t)pn * tbytes; return true; } };
struct EpiHid { bf16_t* HID;
    __device__ __forceinline__ void pre(acc_t& acc, const pg8::Unit& u, int wr, int wc, int fr, int fq) const {
#pragma unroll
        for (int ai = 0; ai < 2; ++ai) if (ai == 0 || !u.half)
#pragma unroll
            for (int m = 0; m < 4; ++m)
#pragma unroll
                for (int n = 0; n < 2; ++n) { const f32x4 g = acc[ai][0][m][n], uu = acc[ai][1][m][n]; f32x4 h; h.x = siluf_(g.x) * uu.x; h.y = siluf_(g.y) * uu.y; h.z = siluf_(g.z) * uu.z; h.w = siluf_(g.w) * uu.w;
                    const uint2 w = pk4(h); acc[ai][0][m][n].x = __uint_as_float(w.x); acc[ai][0][m][n].y = __uint_as_float(w.y); }
    }
    __device__ __forceinline__ void st(const acc_t& acc, const pg8::Unit& u, int wr, int wc, int fr, int fq) const {
#pragma unroll
        for (int ai = 0; ai < 2; ++ai) if (ai == 0 || !u.half)
#pragma unroll
            for (int m = 0; m < 4; ++m) {
                const int row = u.pm * 256 + ai * 128 + wr * 64 + m * 16 + fr; bf16_t* p = HID + ((size_t)u.e * EROWS + row) * DE + u.pn * 128 + wc * 32 + 8 * fq;
                *(u32x4_t*)p = (u32x4_t){__float_as_uint(acc[ai][0][m][0].x), __float_as_uint(acc[ai][0][m][0].y), __float_as_uint(acc[ai][0][m][1].x), __float_as_uint(acc[ai][0][m][1].y)};
            }
    } };
__device__ __forceinline__ void phase_gemm1(const Frame& F, int l) {
    const int RT = l == 0 ? 9 : 8;
    SchedG S; S.o.init(NE * RT, 2 * DE / 256, RT, F.G, F.bid); S.A = (const char*)F.XS; S.B = (const char*)(F.WGU + (size_t)l * NE * 2 * DE * D); S.RT = RT;
    S.a_estride = (size_t)EROWS * D * 2; S.b_estride = (size_t)2 * DE * D * 2; S.tbytes = (size_t)256 * D * 2; S.nt = D / 64;
    EpiHid E{F.HID};
    pg8::gemm_phase<EpiHid, SchedG, true>((LAS unsigned char*)F.lds, F.tid, D, S, E);
}
struct EpiY { bf16_t* Y; bf16_t* YP;
    __device__ __forceinline__ void pre(acc_t& acc, const pg8::Unit& u, int wr, int wc, int fr, int fq) const {
#pragma unroll
        for (int ai = 0; ai < 2; ++ai) if (ai == 0 || !u.half)
#pragma unroll
            for (int m = 0; m < 4; ++m)
#pragma unroll
                for (int bj = 0; bj < 2; ++bj)
#pragma unroll
                    for (int n = 0; n < 2; ++n) { const uint2 w = pk4(acc[ai][bj][m][n]); acc[ai][bj][m][n].x = __uint_as_float(w.x); acc[ai][bj][m][n].y = __uint_as_float(w.y); }
    }
    __device__ __forceinline__ void st(const acc_t& acc, const pg8::Unit& u, int wr, int wc, int fr, int fq) const {
        asm volatile("" : "+v"(fr), "+v"(fq));
        bf16_t* base = (u.half >= 2 ? YP + (size_t)((u.half - 2) * NE + u.e) * 128 * D : Y + ((size_t)u.e * EROWS + u.pm * 256) * D) + u.pn * 256 + wc * 32 + 8 * fq;
#pragma unroll
        for (int ai = 0; ai < 2; ++ai) if (ai == 0 || !u.half)
#pragma unroll
            for (int m = 0; m < 4; ++m) {
                bf16_t* p = base + (size_t)(ai * 128 + wr * 64 + m * 16 + fr) * D;
#pragma unroll
                for (int bj = 0; bj < 2; ++bj)
                    *(u32x4_t*)(p + bj * 128) = (u32x4_t){__float_as_uint(acc[ai][bj][m][0].x), __float_as_uint(acc[ai][bj][m][0].y), __float_as_uint(acc[ai][bj][m][1].x), __float_as_uint(acc[ai][bj][m][1].y)};
            }
    } };
struct SchedG2 { pg8::TileOrder o; const char* A; const char* B; size_t a_estride, b_estride, tbytes;
    __device__ __forceinline__ bool next(int i, pg8::Unit& u) const { int pm, pn;
        if (o.decode(i, pm, pn)) { const int e = pm >> 3, rt = pm & 7; u.pm = rt; u.pn = pn; u.e = e; u.half = 0; u.nt = DE / 64;
            u.a = A + (size_t)e * a_estride + (size_t)rt * tbytes; u.b = B + (size_t)e * b_estride + (size_t)pn * tbytes; return true; }
        const long Lx = (long)i * o.G + o.c - o.nwg; if (Lx >= NE * 16) return false;
        const int L = (int)Lx, e = L >> 4, kq = L & 3; pn = (L >> 2) & 3; u.pm = 8; u.pn = pn; u.e = e; u.half = 2 + kq; u.nt = DE / 64 / 4;
        u.a = A + (size_t)e * a_estride + (size_t)8 * tbytes + (size_t)kq * (DE / 4) * 2; u.b = B + (size_t)e * b_estride + (size_t)pn * tbytes + (size_t)kq * (DE / 4) * 2; return true; } };
__device__ __forceinline__ void phase_gemm2(const Frame& F, int l) {
    EpiY E{F.Y, (bf16_t*)F.OF};
    if (l == 0) {
        SchedG2 S; S.o.init(NE * 8, D / 256, 8, F.G, F.bid); S.A = (const char*)F.HID; S.B = (const char*)F.WD;
        S.a_estride = (size_t)EROWS * DE * 2; S.b_estride = (size_t)D * DE * 2; S.tbytes = (size_t)256 * DE * 2;
        pg8::gemm_phase<EpiY, SchedG2, true>((LAS unsigned char*)F.lds, F.tid, DE, S, E);
    } else {
        SchedG S; S.o.init(NE * 8, D / 256, 8, F.G, F.bid); S.A = (const char*)F.HID; S.B = (const char*)(F.WD + (size_t)l * NE * D * DE); S.RT = 8; S.nt = DE / 64;
        S.a_estride = (size_t)EROWS * DE * 2; S.b_estride = (size_t)D * DE * 2; S.tbytes = (size_t)256 * DE * 2;
        pg8::gemm_phase<EpiY, SchedG, true>((LAS unsigned char*)F.lds, F.tid, DE, S, E);
    }
}

typedef float f32x16 __attribute__((ext_vector_type(16)));
__device__ __forceinline__ bf16x8 mk8(s16x4 lo, s16x4 hi) { return (bf16x8){lo[0], lo[1], lo[2], lo[3], hi[0], hi[1], hi[2], hi[3]}; }
constexpr int ATT_KROW = 72, ATT_TILE = 2 * 32 * ATT_KROW, ATT_BUF = 2 * ATT_TILE;
__device__ __forceinline__ void attn_unit(const Frame& F, int l, int unit) {
    const int tid = F.tid, wave = F.wave, lane = F.lane;
    const bool cq = unit >= 512;
    int b, kv, qb;
    if (!cq) { qb = unit & 63; kv = (unit >> 6) & 1; b = unit >> 7; } else { const int u = unit - 512; qb = u & 3; kv = (u >> 2) & 1; b = u >> 3; }
    const int g = wave >> 1, head = kv * 4 + g, ql = lane & 31, h = lane >> 5;
    const int q0 = qb * 64, tq0 = q0 + (wave & 1) * 32;
    const int qrow = (cq ? NLAT + b * L : b * T) + tq0 + ql;
    bf16x8 qf[4];
#pragma unroll
    for (int ks = 0; ks < 4; ++ks) qf[ks] = *(const bf16x8*)(F.PL + (size_t)qrow * INC + OFF_Q + head * 64 + 16 * ks + 8 * h);
    int jb0 = 0, jb1 = 0;
    if (!cq) { jb0 = (q0 >> 5) - 4; if (jb0 < 0) jb0 = 0; jb1 = (q0 >> 5) + 6; if (jb1 > T / 32) jb1 = T / 32; }
    const int nlb = jb1 - jb0, ntb = nlb + L / 32, npair = ntb >> 1;
    LAS bf16_t* lbuf = (LAS bf16_t*)(LAS unsigned char*)F.lds;
    const bool isk = tid < 256; const int sr = (tid & 255) >> 3, sc = tid & 7;
    const int sdst = (isk ? 0 : 32 * ATT_KROW) + sr * ATT_KROW + sc * 8;
    u32x4_t stg0, stg1;
#define ATT_GLOAD1(tt, REG) do { const bool isl_ = (tt) < nlb; const int jt_ = isl_ ? jb0 + (tt) : (tt) - nlb; \
        const bf16_t* src_ = F.PL + (size_t)((isl_ ? b * T : NLAT + b * L) + jt_ * 32 + sr) * INC + (isk ? OFF_K : OFF_V) + kv * 64 + sc * 8; \
        REG = *(const u32x4_t*)src_; } while (0)
#define ATT_LWRITE1(off, REG) do { LAS bf16_t* d_ = lbuf + (off) + sdst; *(LAS u32x2_t*)d_ = (u32x2_t){REG.x, REG.y}; *(LAS u32x2_t*)(d_ + 4) = (u32x2_t){REG.z, REG.w}; } while (0)
    const float C2 = 0.125f * 1.4426950408889634f;
    float m = -1e30f, lsum = 0.f;
    f32x16 o0, o1;
#pragma unroll
    for (int r = 0; r < 16; ++r) { o0[r] = 0.f; o1[r] = 0.f; }
    ATT_GLOAD1(0, stg0); ATT_GLOAD1(1, stg1); ATT_LWRITE1(0, stg0); ATT_LWRITE1(ATT_TILE, stg1);
    __syncthreads();
    for (int pi = 0; pi < npair; ++pi) {
        if (pi + 1 < npair) { ATT_GLOAD1(2 * pi + 2, stg0); ATT_GLOAD1(2 * pi + 3, stg1); }
        LAS bf16_t* bufp = lbuf + (pi & 1) * ATT_BUF;
        f32x16 S[2];
        {
            bf16x8 kf[2][4];
#pragma unroll
            for (int tp = 0; tp < 2; ++tp)
#pragma unroll
                for (int ks = 0; ks < 4; ++ks) kf[tp][ks] = *(const LAS bf16x8*)(bufp + tp * ATT_TILE + ql * ATT_KROW + 16 * ks + 8 * h);
#pragma unroll
            for (int r = 0; r < 16; ++r) { S[0][r] = 0.f; S[1][r] = 0.f; }
#pragma unroll
            for (int ks = 0; ks < 4; ++ks) {
                S[0] = __builtin_amdgcn_mfma_f32_32x32x16_bf16(kf[0][ks], qf[ks], S[0], 0, 0, 0);
                S[1] = __builtin_amdgcn_mfma_f32_32x32x16_bf16(kf[1][ks], qf[ks], S[1], 0, 0, 0);
            }
        }
        float mt = -1e30f;
#pragma unroll
        for (int tp = 0; tp < 2; ++tp) {
            const int ti = 2 * pi + tp; const bool isl = ti < nlb; const int dj = (jb0 + ti) * 32 - tq0;
            const bool edge = isl && (dj <= -128 || dj >= 128);
            if (edge) {
#pragma unroll
                for (int r = 0; r < 16; ++r) { const int dd = dj + (r & 3) + 8 * (r >> 2) + 4 * h - ql; if (dd > 128 || dd < -128) S[tp][r] = -1e30f; }
            }
#pragma unroll
            for (int r = 0; r < 16; ++r) mt = fmaxf(mt, S[tp][r]);
        }
        { const auto rr = __builtin_amdgcn_permlane32_swap(__float_as_uint(mt), __float_as_uint(mt), false, false); mt = fmaxf(__uint_as_float(rr[0]), __uint_as_float(rr[1])); }
        const float mts = mt * C2;
        if (!__all(mts <= m + 8.f)) {
            const float mn = fmaxf(m, mts);
            const float alpha = __builtin_amdgcn_exp2f(m - mn);
            m = mn; lsum *= alpha;
#pragma unroll
            for (int r = 0; r < 16; ++r) { o0[r] *= alpha; o1[r] *= alpha; }
        }
        float ps = 0.f;
        const float negm = -m;
#pragma unroll
        for (int tp = 0; tp < 2; ++tp)
#pragma unroll
            for (int r = 0; r < 16; ++r) { S[tp][r] = __builtin_amdgcn_exp2f(__builtin_fmaf(S[tp][r], C2, negm)); ps += S[tp][r]; }
        lsum += ps;
#pragma unroll
        for (int tp = 0; tp < 2; ++tp) {
            LAS unsigned char* vb = (LAS unsigned char*)(bufp + tp * ATT_TILE + 32 * ATT_KROW) + (4 * h + ((lane & 15) >> 2)) * (ATT_KROW * 2) + (16 * ((lane >> 4) & 1) + 4 * (lane & 3)) * 2;
#pragma unroll
            for (int sx = 0; sx < 2; ++sx) {
                const uint4 wv = make_uint4(cvtpk(S[tp][8 * sx + 0], S[tp][8 * sx + 1]), cvtpk(S[tp][8 * sx + 2], S[tp][8 * sx + 3]), cvtpk(S[tp][8 * sx + 4], S[tp][8 * sx + 5]), cvtpk(S[tp][8 * sx + 6], S[tp][8 * sx + 7]));
                const bf16x8 pb = __builtin_bit_cast(bf16x8, wv);
                LAS unsigned char* v0 = vb + (16 * sx) * (ATT_KROW * 2);
                o0 = __builtin_amdgcn_mfma_f32_32x32x16_bf16(mk8(lds_tr(v0), lds_tr(v0 + 8 * ATT_KROW * 2)), pb, o0, 0, 0, 0);
                o1 = __builtin_amdgcn_mfma_f32_32x32x16_bf16(mk8(lds_tr(v0 + 64), lds_tr(v0 + 8 * ATT_KROW * 2 + 64)), pb, o1, 0, 0, 0);
            }
        }
        if (pi + 1 < npair) { ATT_LWRITE1(((pi + 1) & 1) * ATT_BUF, stg0); ATT_LWRITE1(((pi + 1) & 1) * ATT_BUF + ATT_TILE, stg1); }
        __syncthreads();
    }
#undef ATT_GLOAD1
#undef ATT_LWRITE1
    { const auto rr = __builtin_amdgcn_permlane32_swap(__float_as_uint(lsum), __float_as_uint(lsum), false, false); lsum = __uint_as_float(rr[0]) + __uint_as_float(rr[1]); }
    const float sk = F.attn_sink[l * 8 + head] * 1.4426950408889634f;
    const float mf = fmaxf(m, sk);
    const float alpha = __builtin_amdgcn_exp2f(m - mf);
    lsum = lsum * alpha + __builtin_amdgcn_exp2f(sk - mf);
    const float sc2 = alpha / lsum;
    bf16_t* op = F.MIXIN + (size_t)qrow * D + head * 64 + 4 * h;
#pragma unroll
    for (int r4 = 0; r4 < 4; ++r4) {
        uint2 w; w.x = cvtpk(o0[4 * r4] * sc2, o0[4 * r4 + 1] * sc2); w.y = cvtpk(o0[4 * r4 + 2] * sc2, o0[4 * r4 + 3] * sc2); *(uint2*)(op + 8 * r4) = w;
        uint2 w2; w2.x = cvtpk(o1[4 * r4] * sc2, o1[4 * r4 + 1] * sc2); w2.y = cvtpk(o1[4 * r4 + 2] * sc2, o1[4 * r4 + 3] * sc2); *(uint2*)(op + 32 + 8 * r4) = w2;
    }
}

__device__ __forceinline__ int hg_row(int b, int j, int dir, int tau) { const int pos = 64 * j + (dir ? 63 - tau : tau); return row_of_pos(b, pos); }


__device__ __forceinline__ bf16x8 mk8z(s16x4 lo) { return (bf16x8){lo[0], lo[1], lo[2], lo[3], 0, 0, 0, 0}; }
__device__ __forceinline__ void hgrn_a_item(const Frame& F, int l, int item, int lane, int w) {
    const int dir = item & 1, h = (item >> 1) & 3, j = (item >> 3) % NSC, b = item / (8 * NSC);
    const int i16 = lane & 15, q = lane >> 4;
    LAS unsigned char* wl = (LAS unsigned char*)F.lds + w * 16384;
    LAS bf16_t* KD = (LAS bf16_t*)wl; LAS bf16_t* Vv = (LAS bf16_t*)(wl + 8192);
    const int zoff = (dir ? OFF_FB : OFF_FF) + h * 64 + lane;
    float suffix = 0.f;
    bf16_t zr[64];
#pragma unroll
    for (int t = 0; t < 64; ++t) zr[t] = (F.PL + (size_t)hg_row(b, j, dir, t) * INC)[zoff];
    wave_lds_sync();
#pragma unroll
    for (int t = 63; t >= 0; --t) {
        const float lf = bf2f(zr[t]);
        KD[t * 64 + lane] = f2bfq((1.f - __expf(lf)) * __expf(suffix));
        suffix += lf;
    }
    const size_t base = (size_t)(((b * 2 + dir) * NSC + j) * 4 + h);
    F.HD[base * 64 + lane] = __expf(suffix);
#pragma unroll
    for (int i = 0; i < 8; ++i) { const int sg = (lane >> 3) + 8 * i; const int row = hg_row(b, j, dir, sg);
        const u32x4_t v = *(const u32x4_t*)(F.PL + (size_t)row * INC + OFF_I + h * 64 + (lane & 7) * 8); *(LAS u32x4_t*)(Vv + sg * 64 + (lane & 7) * 8) = v; }
    wave_lds_sync();
    f32x4 U[4][4];
#pragma unroll
    for (int dt = 0; dt < 4; ++dt)
#pragma unroll
        for (int vt = 0; vt < 4; ++vt) U[dt][vt] = (f32x4){0.f, 0.f, 0.f, 0.f};
#pragma unroll
    for (int ks = 0; ks < 2; ++ks) {
        bf16x8 af[4], bfr[4];
        const int r0 = (32 * ks + 4 * q + (i16 >> 2)) * 128 + 8 * (i16 & 3);
#pragma unroll
        for (int t4 = 0; t4 < 4; ++t4) {
            af[t4] = mk8(lds_tr((LAS unsigned char*)KD + r0 + 32 * t4), lds_tr((LAS unsigned char*)KD + r0 + 16 * 128 + 32 * t4));
            bfr[t4] = mk8(lds_tr((LAS unsigned char*)Vv + r0 + 32 * t4), lds_tr((LAS unsigned char*)Vv + r0 + 16 * 128 + 32 * t4));
        }
#pragma unroll
        for (int dt = 0; dt < 4; ++dt)
#pragma unroll
            for (int vt = 0; vt < 4; ++vt) U[dt][vt] = __builtin_amdgcn_mfma_f32_16x16x32_bf16(af[dt], bfr[vt], U[dt][vt], 0, 0, 0);
    }
    bf16_t* Uo = F.HU + base * 4096 + lane * 4;
#pragma unroll
    for (int dt = 0; dt < 4; ++dt)
#pragma unroll
        for (int vt = 0; vt < 4; ++vt) *(uint2*)(Uo + (dt * 4 + vt) * 256) = pk4(U[dt][vt]);
}

__device__ __forceinline__ void phase_hgrn_b(const Frame& F) {
    const bf16_t* __restrict__ HU = F.HU; const float* __restrict__ HD = F.HD; bf16_t* __restrict__ SB = F.SB;
    for (int idx = F.bid * NTHREADS + F.tid; idx < NB * 2 * 4 * 4096; idx += F.G * NTHREADS) {
        const int e = idx & 4095, h = (idx >> 12) & 3, dir = (idx >> 14) & 1, b = idx >> 15;
        const int d = 16 * (e >> 10) + 4 * ((e >> 6) & 3) + (e & 3);
        float S = 0.f;
        for (int p0 = 0; p0 < NSC; p0 += 17) {
            float u[17], dd[17]; size_t bs[17];
#pragma unroll
            for (int i = 0; i < 17; ++i) { const int p = p0 + i; const int j = dir ? (p < 4 ? 3 - p : 71 - p) : p; bs[i] = (size_t)(((b * 2 + dir) * NSC + j) * 4 + h); u[i] = bf2f(HU[bs[i] * 4096 + e]); dd[i] = HD[bs[i] * 64 + d]; }
#pragma unroll
            for (int i = 0; i < 17; ++i) { SB[bs[i] * 4096 + e] = f2bfq(S); S = dd[i] * S + u[i]; }
        }
    }
}

constexpr int HGC_WL = 14848;
__device__ __forceinline__ void hgrn_c_block(const Frame& F, int l, int item) {
    const int lane = F.lane, w = F.wave, h = w & 3, dir = w >> 2, j = item % NSC, b = item / NSC;
    const int i16 = lane & 15, q = lane >> 4;
    LAS unsigned char* wl = (LAS unsigned char*)F.lds + w * HGC_WL;
    LAS bf16_t* Qp = (LAS bf16_t*)wl; LAS bf16_t* Kp = (LAS bf16_t*)(wl + 2048); LAS bf16_t* Vv = (LAS bf16_t*)(wl + 4096);
    LAS float* hv = (LAS float*)(wl + 6144); LAS float* gv = (LAS float*)(wl + 6400); LAS bf16_t* Ot = (LAS bf16_t*)(wl + 6656);
    const int zoff = (dir ? OFF_FB : OFF_FF) + h * 64 + lane, qoff = OFF_HQ + h * 64 + lane;
    const size_t base = (size_t)(((b * 2 + dir) * NSC + j) * 4 + h);
    f32x4 S[4][4];
    { const bf16_t* sb = F.SB + base * 4096 + lane * 4;
#pragma unroll
    for (int dt = 0; dt < 4; ++dt)
#pragma unroll
        for (int vt = 0; vt < 4; ++vt) { const uint2 w = *(const uint2*)(sb + (dt * 4 + vt) * 256);
            S[dt][vt] = (f32x4){__uint_as_float(w.x << 16), __uint_as_float(w.x & 0xffff0000u), __uint_as_float(w.y << 16), __uint_as_float(w.y & 0xffff0000u)}; } }
    bf16_t zr[16], hr[16]; u32x4_t vr[2];
    const int vlane = OFF_I + h * 64 + (lane & 7) * 8;
#define HGC_LOAD(cc) do { _Pragma("unroll") for (int tau = 0; tau < 16; ++tau) { const bf16_t* prow = F.PL + (size_t)hg_row(b, j, dir, (cc) * 16 + tau) * INC; zr[tau] = prow[zoff]; hr[tau] = prow[qoff]; } \
        _Pragma("unroll") for (int i = 0; i < 2; ++i) { const int row = hg_row(b, j, dir, (cc) * 16 + (lane >> 3) + 8 * i); vr[i] = *(const u32x4_t*)(F.PL + (size_t)row * INC + vlane); } } while (0)
    HGC_LOAD(0);
    for (int c = 0; c < 4; ++c) {
        {
            float kk[16], lam[16], qq[16]; float run = 0.f;
#pragma unroll
            for (int tau = 0; tau < 16; ++tau) {
                const float lf = bf2f(zr[tau]);
                kk[tau] = 1.f - __expf(lf);
                run += lf; lam[tau] = run;
                qq[tau] = bf2f(hr[tau]);
            }
            const float lmid = lam[7];
            wave_lds_sync();
#pragma unroll
            for (int tau = 0; tau < 16; ++tau) { Qp[tau * 64 + lane] = f2bfq(qq[tau] * __expf(fminf(lam[tau] - lmid, 60.f))); Kp[tau * 64 + lane] = f2bfq(kk[tau] * __expf(fminf(lmid - lam[tau], 60.f))); }
            hv[lane] = __expf(lmid); gv[lane] = __expf(run - lmid);
        }
#pragma unroll
        for (int i = 0; i < 2; ++i) *(LAS u32x4_t*)(Vv + ((lane >> 3) + 8 * i) * 64 + (lane & 7) * 8) = vr[i];
        if (c < 3) HGC_LOAD(c + 1);
        wave_lds_sync();
        bf16x8 afr;
        {
            const bf16x8 ka0 = *(const LAS bf16x8*)(Kp + i16 * 64 + 8 * q), ka1 = *(const LAS bf16x8*)(Kp + i16 * 64 + 32 + 8 * q);
            const bf16x8 qb0 = *(const LAS bf16x8*)(Qp + i16 * 64 + 8 * q), qb1 = *(const LAS bf16x8*)(Qp + i16 * 64 + 32 + 8 * q);
            f32x4 At = (f32x4){0.f, 0.f, 0.f, 0.f};
            At = __builtin_amdgcn_mfma_f32_16x16x32_bf16(ka0, qb0, At, 0, 0, 0);
            At = __builtin_amdgcn_mfma_f32_16x16x32_bf16(ka1, qb1, At, 0, 0, 0);
#pragma unroll
            for (int r = 0; r < 4; ++r) if (4 * q + r > i16) At[r] = 0.f;
            const uint4 wv = make_uint4(cvtpk(At[0], At[1]), cvtpk(At[2], At[3]), 0u, 0u); afr = __builtin_bit_cast(bf16x8, wv);
        }
        const int trb = (4 * q + (i16 >> 2)) * 128 + 8 * (i16 & 3);
        bf16x8 bv[4];
#pragma unroll
        for (int vt = 0; vt < 4; ++vt) bv[vt] = mk8z(lds_tr((LAS unsigned char*)Vv + trb + 32 * vt));
#pragma unroll
        for (int dt = 0; dt < 4; ++dt) { const f32x4 hr = *(const LAS f32x4*)(hv + 16 * dt + 4 * q);
#pragma unroll
            for (int vt = 0; vt < 4; ++vt) S[dt][vt] *= hr; }
        bf16x8 aq[2];
#pragma unroll
        for (int kb = 0; kb < 2; ++kb) { const u32x2_t lo = *(const LAS u32x2_t*)(Qp + i16 * 64 + 32 * kb + 4 * q), hi = *(const LAS u32x2_t*)(Qp + i16 * 64 + 32 * kb + 16 + 4 * q);
            const uint4 wv = make_uint4(lo.x, lo.y, hi.x, hi.y); aq[kb] = __builtin_bit_cast(bf16x8, wv); }
#pragma unroll
        for (int vt = 0; vt < 4; ++vt) {
            f32x4 o = (f32x4){0.f, 0.f, 0.f, 0.f};
#pragma unroll
            for (int kb = 0; kb < 2; ++kb) {
                const f32x4 s0 = S[2 * kb][vt], s1 = S[2 * kb + 1][vt];
                const uint4 wv = make_uint4(cvtpk(s0[0], s0[1]), cvtpk(s0[2], s0[3]), cvtpk(s1[0], s1[1]), cvtpk(s1[2], s1[3]));
                o = __builtin_amdgcn_mfma_f32_16x16x32_bf16(aq[kb], __builtin_bit_cast(bf16x8, wv), o, 0, 0, 0);
            }
            o = __builtin_amdgcn_mfma_f32_16x16x32_bf16(afr, bv[vt], o, 0, 0, 0);
#pragma unroll
            for (int r = 0; r < 4; ++r) { const int t16 = c * 16 + 4 * q + r; const int tok = dir ? 63 - t16 : t16; Ot[tok * 64 + 16 * vt + i16] = f2bfq(o[r]); }
        }
#pragma unroll
        for (int dt = 0; dt < 4; ++dt) {
            const bf16x8 kt = mk8z(lds_tr((LAS unsigned char*)Kp + trb + 32 * dt));
            const f32x4 gr = *(const LAS f32x4*)(gv + 16 * dt + 4 * q);
#pragma unroll
            for (int vt = 0; vt < 4; ++vt) S[dt][vt] = __builtin_amdgcn_mfma_f32_16x16x32_bf16(kt, bv[vt], S[dt][vt], 0, 0, 0) * gr;
        }
    }
#undef HGC_LOAD
    wave_lds_sync();
    __syncthreads();
    {
        const int hh = w & 3, half = w >> 2;
        LAS bf16_t* Of = (LAS bf16_t*)((LAS unsigned char*)F.lds + hh * HGC_WL + 6656); LAS bf16_t* Ob = (LAS bf16_t*)((LAS unsigned char*)F.lds + (hh + 4) * HGC_WL + 6656);
        const float gain = F.hgrn_norm_g[l * 256 + hh * 64 + lane];
#pragma unroll 8
        for (int tk = 0; tk < 32; ++tk) {
            const int tok = half * 32 + tk; const int row = row_of_pos(b, 64 * j + tok);
            const float o = bf2f(Of[tok * 64 + lane]) + bf2f(Ob[tok * 64 + lane]);
            const float ss = wave_sum(o * o);
            const float rstd = rsqrtf(ss * (1.f / 64.f) + 1e-6f);
            const float g = bf2f(F.PL[(size_t)row * INC + OFF_G + hh * 64 + lane]);
            F.MIXIN[(size_t)row * D + 512 + hh * 64 + lane] = f2bfq(o * rstd * gain * g);
        }
    }
    __syncthreads();
}

__device__ __forceinline__ void conv_rows(const Frame& F, int l, int r0, int r1, int tid_in, int nthr) {
    for (int idx = r0 * 32 + tid_in; idx < r1 * 32; idx += nthr) {
        const int r = idx >> 5, c = (idx & 31) * 8;
        int tt, len; if (r < NLAT) { tt = r & (T - 1); len = T; } else { tt = (r - NLAT) & (L - 1); len = L; }
        const bf16_t* row = F.PL + (size_t)r * INC;
        const u32x4_t z4 = (u32x4_t){0u, 0u, 0u, 0u};
        const u32x4_t cb = *(const u32x4_t*)(row + OFF_CB + c), c1 = *(const u32x4_t*)(row + OFF_CC + c), h1 = *(const u32x4_t*)(row + OFF_CH + c);
        const u32x4_t c0 = tt > 0 ? *(const u32x4_t*)(row + OFF_CC + c - INC) : z4, h0 = tt > 0 ? *(const u32x4_t*)(row + OFF_CH + c - INC) : z4;
        const u32x4_t c2 = tt < len - 1 ? *(const u32x4_t*)(row + OFF_CC + c + INC) : z4, h2 = tt < len - 1 ? *(const u32x4_t*)(row + OFF_CH + c + INC) : z4;
        const float* wp = F.conv_w + l * 768 + c;
        u32x4_t o;
#pragma unroll
        for (int i = 0; i < 4; ++i) {
            const float w0a = wp[2 * i], w0b = wp[2 * i + 1], w1a = wp[256 + 2 * i], w1b = wp[256 + 2 * i + 1], w2a = wp[512 + 2 * i], w2b = wp[512 + 2 * i + 1];
#define LO(x) __uint_as_float((x) << 16)
#define HI(x) __uint_as_float((x) & 0xffff0000u)
            const float ua = w0a * (LO(c0[i]) * LO(h0[i])) + w1a * (LO(c1[i]) * LO(h1[i])) + w2a * (LO(c2[i]) * LO(h2[i]));
            const float ub = w0b * (HI(c0[i]) * HI(h0[i])) + w1b * (HI(c1[i]) * HI(h1[i])) + w2b * (HI(c2[i]) * HI(h2[i]));
            o[i] = cvtpk(LO(cb[i]) * ua, HI(cb[i]) * ub);
#undef LO
#undef HI
        }
        *(u32x4_t*)(F.MIXIN + (size_t)r * D + 768 + c) = o;
    }
}

#ifndef PROBE_SUB
#define PROBE_SUB 0
#endif
__device__ __forceinline__ void phase_mix_a(const Frame& F, int l) {
    const int gw = F.bid * NWAVES + F.wave, NGW = F.G * NWAVES;
    for (int rep = 0; rep < 1 + (PROBE_SUB & 1); ++rep)
    for (int it = gw; it < NB * NSC * 4 * 2; it += NGW) hgrn_a_item(F, l, it, F.lane, F.wave);
    for (int rep = 0; rep < 1 + ((PROBE_SUB >> 1) & 1); ++rep)
    conv_rows(F, l, 0, l == 0 ? NROWS : NLAT, F.bid * NTHREADS + F.tid, F.G * NTHREADS);
    const int nat = l == 0 ? 512 + 32 : 512;
    __syncthreads();
    for (int rep = 0; rep < 1 + ((PROBE_SUB >> 2) & 1); ++rep)
    for (int it = F.bid; it < nat; it += F.G) attn_unit(F, l, it);
}

__device__ __forceinline__ void phase_hgrn_c(const Frame& F, int l) {
    if (l == 0) { for (int it = F.bid; it < NB * NSC; it += F.G) hgrn_c_block(F, l, it); }
    else { for (int it = F.bid; it < NB * 64; it += F.G) hgrn_c_block(F, l, (it >> 6) * NSC + 4 + (it & 63)); }
}

__device__ __forceinline__ void phase_norm2(const Frame& F, int l) {
    const int gw = F.bid * NWAVES + F.wave, NGW = F.G * NWAVES, lane = F.lane;
    const int nrows = l == 0 ? NROWS : NLAT;
    const float* RW = F.router_w + (size_t)l * D * NE;
    float* rwt = (float*)F.lds;
    for (int i = F.tid; i < D * NE / 4; i += NTHREADS) { const f32x4 w = *(const f32x4*)(RW + (size_t)i * 4); const int k = i >> 2, e0 = (i & 3) * 4;
        rwt[(e0 + 0) * D + k] = w.x; rwt[(e0 + 1) * D + k] = w.y; rwt[(e0 + 2) * D + k] = w.z; rwt[(e0 + 3) * D + k] = w.w; }
    __syncthreads();
    for (int r = gw; r < nrows; r += NGW) {
        const int mb = modb(r);
        f32x4 v[4]; float ss = 0.f;
#pragma unroll
        for (int j = 0; j < 4; ++j) { v[j] = *(const f32x4*)(F.X + (size_t)r * D + lane * 4 + 256 * j); ss += (v[j].x * v[j].x + v[j].y * v[j].y) + (v[j].z * v[j].z + v[j].w * v[j].w); }
        ss = wave_sum(ss);
        const float rstd = rsqrtf(ss * (1.f / D) + 1e-6f);
        const float* mv = F.MOD + (size_t)(l * 5 + mb) * NMODV;
        float lg[16];
#pragma unroll
        for (int e = 0; e < 16; ++e) lg[e] = 0.f;
#pragma unroll
        for (int j = 0; j < 4; ++j) {
            const int c0 = lane * 4 + 256 * j;
            const f32x4 g = *(const f32x4*)(F.norm2_g + l * D + c0), sh = *(const f32x4*)(mv + 3 * D + c0), sc = *(const f32x4*)(mv + 4 * D + c0);
            const f32x4 h = v[j] * rstd * g * (sc + 1.f) + sh;
            uint2 w; w.x = pk2(h.x, h.y); w.y = pk2(h.z, h.w);
            *(uint2*)(F.HN + (size_t)r * D + c0) = w;
#pragma unroll
            for (int e = 0; e < 16; ++e) { const f32x4 w4 = *(const f32x4*)(rwt + e * D + c0); lg[e] += (h.x * w4.x + h.y * w4.y) + (h.z * w4.z + h.w * w4.w); if ((e & 7) == 7) asm volatile("" ::: "memory"); }
        }
        float mx = -1e30f;
#pragma unroll
        for (int e = 0; e < 16; ++e) { lg[e] = wave_sum(lg[e]); mx = fmaxf(mx, lg[e]); }
        float den = 0.f;
#pragma unroll
        for (int e = 0; e < 16; ++e) { lg[e] = __expf(lg[e] - mx); den += lg[e]; }
        const float inv = 1.f / den;
        float mine = 0.f;
#pragma unroll
        for (int e = 0; e < 16; ++e) if (lane == e) mine = lg[e] * inv;
        if (lane < 16) F.AFF[(size_t)lane * NROWS + r] = mine;
    }
}

__device__ __forceinline__ void topk_item(const Frame& F, int item, int nq) {
    const int nlat = 64 * nq; const bool lat = item < nlat; const int it = lat ? item / nq : item - nlat; const int q = lat ? item % nq : 0; const int b = it >> 4, e = it & 15;
    const int N = lat ? T : L, cap = lat ? CAP_L : CAP_C, rowbase = lat ? b * T : NLAT + b * L, mbase = lat ? b * CAP_L : 4 * CAP_L + b * CAP_C;
    const int share = (CAP_L + nq - 1) / nq;
    const int slo = lat ? q * share : 0, shi = lat ? (q * share + share < CAP_L ? q * share + share : CAP_L) : CAP_C;
    const int ept = lat ? 8 : 1; const int nact = N / ept; const bool act = F.tid < nact;
    unsigned* wc = (unsigned*)F.lds;
    int* sel = (int*)F.lds + 16;
    unsigned ku[8];
#pragma unroll
    for (int i = 0; i < 8; ++i) ku[i] = 0u;
    if (act) {
        const float* ap = F.AFF + (size_t)e * NROWS + rowbase + F.tid * ept;
        if (lat) { const u32x4_t a0 = *(const u32x4_t*)ap, a1 = *(const u32x4_t*)(ap + 4); ku[0] = a0.x; ku[1] = a0.y; ku[2] = a0.z; ku[3] = a0.w; ku[4] = a1.x; ku[5] = a1.y; ku[6] = a1.z; ku[7] = a1.w; }
        else ku[0] = __float_as_uint(ap[0]);
    }
    unsigned* hist = (unsigned*)F.lds + 512;
    unsigned* res = hist + 256;
    unsigned thr = 0u, pmask = 0u, need = (unsigned)cap;
    for (int pass = 0; pass < 4; ++pass) {
        const int shift = 24 - 8 * pass;
        if (F.tid < 256) hist[F.tid] = 0u;
        __syncthreads();
        if (act) {
#pragma unroll
            for (int i = 0; i < 8; ++i) if (i < ept) { if ((ku[i] & pmask) == thr) atomicAdd(&hist[(ku[i] >> shift) & 255u], 1u); }
        }
        __syncthreads();
        if (F.wave == 0) {
            const unsigned c0 = hist[4 * F.lane], c1 = hist[4 * F.lane + 1], c2 = hist[4 * F.lane + 2], c3 = hist[4 * F.lane + 3];
            const unsigned sme = (c0 + c1) + (c2 + c3);
            unsigned suf = sme;
#pragma unroll
            for (int o = 1; o < 64; o <<= 1) { const unsigned t = (unsigned)__builtin_amdgcn_ds_bpermute(((F.lane + o) & 63) << 2, (int)suf); if (F.lane + o < 64) suf += t; }
            const unsigned above = suf - sme;
            if (above < need && need <= above + sme) {
                unsigned cum = above; int bin; unsigned rem;
                if (cum + c3 >= need) { bin = 3; rem = need - cum; }
                else { cum += c3; if (cum + c2 >= need) { bin = 2; rem = need - cum; } else { cum += c2; if (cum + c1 >= need) { bin = 1; rem = need - cum; } else { cum += c1; bin = 0; rem = need - cum; } } }
                res[0] = (unsigned)(4 * F.lane + bin); res[1] = rem;
            }
        }
        __syncthreads();
        thr |= res[0] << shift; pmask |= 255u << shift; need = res[1];
    }
    const unsigned tg = (unsigned)cap - need;
    unsigned cg = 0, ce = 0;
    if (act) {
#pragma unroll
        for (int i = 0; i < 8; ++i) if (i < ept) { cg += (ku[i] > thr) ? 1u : 0u; ce += (ku[i] == thr) ? 1u : 0u; }
    }
    unsigned pk = cg | (ce << 16), inc = pk;
#pragma unroll
    for (int o = 1; o < 64; o <<= 1) { const unsigned t = (unsigned)__builtin_amdgcn_ds_bpermute(((F.lane - o) & 63) << 2, (int)inc); if (F.lane >= o) inc += t; }
    if (F.lane == 63) wc[F.wave] = inc;
    __syncthreads();
    unsigned pre = 0, total = 0;
#pragma unroll
    for (int w = 0; w < NWAVES; ++w) { const unsigned t = wc[w]; if (w < F.wave) pre += t; total += t; }
    unsigned excl = pre + inc - pk;
    unsigned pg = excl & 0xffffu, pe = excl >> 16; (void)total;
    if (act) {
#pragma unroll
        for (int i = 0; i < 8; ++i) if (i < ept) {
            const int row = rowbase + F.tid * ept + i; int slot = -1;
            if (ku[i] > thr) slot = (int)pg++;
            else if (ku[i] == thr) { if (pe < need) slot = (int)(tg + pe); ++pe; }
            if (slot >= slo && slot < shi) { sel[slot - slo] = row; F.GATEV[e * EROWS + mbase + slot] = __uint_as_float(ku[i]); }
            if (q == 0) F.SLOT[(size_t)row * 16 + e] = slot >= 0 ? mbase + slot : -1;
        }
    }
    __syncthreads();
    const int nsl = shi - slo;
    for (int s0 = F.wave * 4; s0 < nsl; s0 += NWAVES * 4) {
        u32x4_t va[4], vb[4];
#pragma unroll
        for (int i = 0; i < 4; ++i) { const int sidx = s0 + i < nsl ? s0 + i : nsl - 1; const u32x4_t* src = (const u32x4_t*)(F.HN + (size_t)sel[sidx] * D) + F.lane * 2; va[i] = src[0]; vb[i] = src[1]; }
#pragma unroll
        for (int i = 0; i < 4; ++i) if (s0 + i < nsl) { u32x4_t* dst = (u32x4_t*)(F.XS + ((size_t)e * EROWS + mbase + slo + s0 + i) * D) + F.lane * 2; dst[0] = va[i]; dst[1] = vb[i]; }
    }
    if (!lat && b == 0) {
        for (int i = F.tid; i < EROWS - (4 * CAP_L + 4 * CAP_C); i += NTHREADS) F.GATEV[e * EROWS + 4 * CAP_L + 4 * CAP_C + i] = 0.f;
        uint4* z = (uint4*)(F.XS + ((size_t)e * EROWS + 4 * CAP_L + 4 * CAP_C) * D);
        for (int i = F.tid; i < (EROWS - (4 * CAP_L + 4 * CAP_C)) * D / 8; i += NTHREADS) z[i] = make_uint4(0u, 0u, 0u, 0u);
    }
}

__device__ __forceinline__ void phase_topk(const Frame& F, int l) {
    const int nq = l == 0 ? (F.G < 256 ? 2 : 3) : 4;
    const int n = l == 0 ? 64 * nq + 64 : 64 * 4;
    for (int it = F.bid; it < n; it += F.G) { topk_item(F, it, nq); __syncthreads(); }
}

#define XB_TMO      128
#define XB_XCNT(j)  (256  + 64 * (j))
#define XB_XSUB(j)  (1280 + 64 * (j))
#define XB_XGEN(j)  (2304 + 64 * (j))
#define XB_TOP      3328
#define XB_TOPGEN   3392
#define XCD_BAR_WORDS 3456
#define XB_SPIN_CAP (1u << 20)
__device__ __forceinline__ unsigned xb_ld(unsigned* p)              { return __hip_atomic_load(p, __ATOMIC_RELAXED, __HIP_MEMORY_SCOPE_AGENT); }
__device__ __forceinline__ unsigned xb_add(unsigned* p, unsigned v) { return __hip_atomic_fetch_add(p, v, __ATOMIC_RELAXED, __HIP_MEMORY_SCOPE_AGENT); }
__device__ __forceinline__ unsigned xb_xcc_id() { return (unsigned)__builtin_amdgcn_s_getreg((3 << 11) | 20) & 0xFu; }
#define XB_SPIN(cond, bar) do { unsigned _sp = 0; while (cond) { __builtin_amdgcn_s_sleep(1); \
    if ((++_sp & 255u) == 0u) { if (xb_ld(&(bar)[XB_TMO])) break; if (_sp > XB_SPIN_CAP) { atomicAdd(&(bar)[XB_TMO], 1u); break; } } } } while (0)
struct XcdBarrier { unsigned* bar; unsigned x; volatile LAS unsigned* st; unsigned gsize; };
__device__ __forceinline__ XcdBarrier xcd_barrier_post(unsigned* bar, volatile LAS unsigned* st, unsigned gsize) {
    XcdBarrier b; b.bar = bar; b.x = xb_xcc_id(); b.st = st; b.gsize = gsize;
    if (threadIdx.x == 0) (void)xb_add(&bar[XB_XCNT(b.x)], 1u);
    return b;
}
__device__ __forceinline__ void xcd_barrier_complete(unsigned* bar, unsigned x, unsigned& nloc, unsigned& nx, const unsigned G) {
    unsigned sum, cnt, mine, sp = 0u;
    for (;;) {
        sum = 0u; cnt = 0u; mine = 0u;
#pragma nounroll
        for (unsigned j = 0; j < 16; ++j) { const unsigned c = xb_ld(&bar[XB_XCNT(j)]); sum += c; cnt += (c > 0u) ? 1u : 0u; mine = (j == x) ? c : mine; }
        if (sum == G) break;
        __builtin_amdgcn_s_sleep(1);
        if ((++sp & 255u) == 0u) { if (xb_ld(&bar[XB_TMO])) break; if (sp > XB_SPIN_CAP) { atomicAdd(&bar[XB_TMO], 1u); break; } }
    }
    nloc = mine > 0u ? mine : 1u; nx = cnt > 0u ? cnt : 1u;
}
__device__ __forceinline__ void xcd_barrier(const XcdBarrier& b) {
    asm volatile("s_waitcnt vmcnt(0)" ::: "memory");
    __syncthreads();
    if (threadIdx.x == 0) {
        unsigned* bar = b.bar;
        __builtin_amdgcn_s_waitcnt(0);
        unsigned nloc = b.st[0], nx = b.st[1];
        if (nloc == 0u) { xcd_barrier_complete(bar, b.x, nloc, nx, b.gsize); b.st[0] = nloc; b.st[1] = nx; }
        const unsigned old = xb_add(&bar[XB_XSUB(b.x)], 1u);
        const unsigned gen = old / nloc;
        if (old + 1u == (gen + 1u) * nloc) {
            __builtin_amdgcn_fence(__ATOMIC_RELEASE, "agent");
            asm volatile("s_waitcnt vmcnt(0)" ::: "memory");
            const unsigned og = xb_add(&bar[XB_TOP], 1u);
            const unsigned tg = og / nx;
            if (og + 1u == (tg + 1u) * nx) xb_add(&bar[XB_TOPGEN], 1u);
            else XB_SPIN(xb_ld(&bar[XB_TOPGEN]) == tg, bar);
            __builtin_amdgcn_fence(__ATOMIC_ACQUIRE, "agent");
            xb_add(&bar[XB_XGEN(b.x)], 1u);
            asm volatile("s_waitcnt vmcnt(0)" ::: "memory");
        } else {
            XB_SPIN(xb_ld(&bar[XB_XGEN(b.x)]) == gen, bar);
            __builtin_amdgcn_fence(__ATOMIC_ACQUIRE, "agent");
            asm volatile("s_waitcnt vmcnt(0)" ::: "memory");
        }
    }
    __syncthreads();
}

__device__ __forceinline__ void run_phase(const Frame& F, int ph) {
    if (ph == 0) { phase_pre(F); return; }
    if (ph == NPHASES - 1) { phase_norm1<2>(F); return; }
    const int l = (ph - 1) / 10, s = (ph - 1) % 10;
    switch (s) {
        case 0: if (l == 0) phase_norm1<0>(F); else phase_norm1<1>(F); break;
        case 1: phase_gemm_in(F, l); break;
        case 2: phase_mix_a(F, l); break;
        case 3: phase_hgrn_b(F); break;
        case 4: phase_hgrn_c(F, l); break;
        case 5: phase_gemm_o(F, l); break;
        case 6: phase_norm2(F, l); break;
        case 7: phase_topk(F, l); break;
        case 8: phase_gemm1(F, l); break;
        default: phase_gemm2(F, l); break;
    }
}

template <int OFF> __device__ __forceinline__ unsigned long long ldarg() {
    unsigned long long v; asm volatile("s_load_dwordx2 %0, %1, %2\n\ts_waitcnt lgkmcnt(0)" : "=s"(v) : "s"(__builtin_amdgcn_kernarg_segment_ptr()), "i"(OFF) : "memory"); return v; }
__device__ __forceinline__ void fill_frame(Frame& F, unsigned char* lds, int vbid, int vG) {
    int tid = threadIdx.x; asm volatile("" : "+v"(tid));
    int bid = __builtin_amdgcn_readfirstlane(vbid), G = __builtin_amdgcn_readfirstlane(vG); asm volatile("" : "+s"(bid), "+s"(G));
    F.lds = lds; F.tid = tid; F.lane = tid & 63; F.wave = __builtin_amdgcn_readfirstlane(tid >> 6); F.bid = bid; F.G = G;
    F.x = (const float*)(const GAS float*)ldarg<0>(); F.c = (const float*)(const GAS float*)ldarg<8>(); F.ctx = (const float*)(const GAS float*)ldarg<16>(); F.c_ctx = (const float*)(const GAS float*)ldarg<24>(); F.ada_w = (const float*)(const GAS float*)ldarg<32>(); F.ada_b = (const float*)(const GAS float*)ldarg<40>();
    F.norm1_g = (const float*)(const GAS float*)ldarg<48>(); F.norm2_g = (const float*)(const GAS float*)ldarg<56>(); F.w_in = (const float*)(const GAS float*)ldarg<64>(); F.attn_sink = (const float*)(const GAS float*)ldarg<72>(); F.hgrn_lb = (const float*)(const GAS float*)ldarg<80>();
    F.hgrn_norm_g = (const float*)(const GAS float*)ldarg<88>(); F.conv_w = (const float*)(const GAS float*)ldarg<96>(); F.w_o = (const float*)(const GAS float*)ldarg<104>(); F.router_w = (const float*)(const GAS float*)ldarg<112>(); F.wg = (const float*)(const GAS float*)ldarg<120>();
    F.wu = (const float*)(const GAS float*)ldarg<128>(); F.wd = (const float*)(const GAS float*)ldarg<136>(); F.final_g = (const float*)(const GAS float*)ldarg<144>(); F.out = (float*)(GAS float*)ldarg<152>();
    unsigned char* ws = (unsigned char*)(GAS unsigned char*)ldarg<160>();
    F.MOD = (float*)(ws + WS_MOD); F.COS = (float*)(ws + WS_COS); F.SIN = (float*)(ws + WS_SIN); F.AFF = (float*)(ws + WS_AFF); F.SLOT = (int*)(ws + WS_SLOT);
    F.ROWMAP = (int*)(ws + WS_ROWMAP); F.GATEV = (float*)(ws + WS_GATEV); F.HD = (float*)(ws + WS_HD); F.HU = (bf16_t*)(ws + WS_HU); F.SB = (bf16_t*)(ws + WS_SB);
    F.OF = (float*)(ws + WS_OF); F.X = (float*)(ws + WS_X); F.HN = (bf16_t*)(ws + WS_HN); F.PL = (bf16_t*)(ws + WS_PL); F.MIXIN = (bf16_t*)(ws + WS_MIXIN);
    F.HID = (bf16_t*)(ws + WS_HID); F.Y = (bf16_t*)(ws + WS_Y); F.WIN = (bf16_t*)(ws + WS_WIN); F.WO = (bf16_t*)(ws + WS_WO); F.WGU = (bf16_t*)(ws + WS_WGU); F.WD = (bf16_t*)(ws + WS_WD); F.XS = (bf16_t*)(ws + WS_PL); F.VTL = (bf16_t*)(ws + WS_VTL); F.VTC = (bf16_t*)(ws + WS_VTC); F.MODP = (float*)(ws + WS_MODP); F.LBT = (float*)(ws + WS_LBT);
}

__global__ void __launch_bounds__(NTHREADS, 2) mk_fwd(Args args) {
    extern __shared__ __attribute__((aligned(16))) unsigned char lds[];
    unsigned char* ws = args.ws;
    const int G = gridDim.x, bid = blockIdx.x;
#ifndef TR_GS
#define TR_GS 32
#endif
    const bool split = (G % TR_GS) == 0;
    const int grp = bid / TR_GS, idx = bid % TR_GS;
    const bool front = !split || idx < TR_GS - 8;
    const int NF = split ? (G / TR_GS) * (TR_GS - 8) : G, NT = G - NF;
    const int vb = !split ? bid : (front ? grp * (TR_GS - 8) + idx : grp * 8 + (idx - (TR_GS - 8)));
    volatile LAS unsigned* st = (volatile LAS unsigned*)(LAS unsigned char*)(lds + LDS_BYTES - 16);
    if (threadIdx.x == 0) { st[0] = 0u; st[1] = 0u; st[2] = 0u; st[3] = 0u; }
    __syncthreads();
    XcdBarrier bar = xcd_barrier_post((unsigned*)(ws + WS_CTL), st, (unsigned)G);
    XcdBarrier barf = bar;
    if (split && front) barf = xcd_barrier_post((unsigned*)(ws + WS_CTL) + XCD_BAR_WORDS, st + 2, (unsigned)NF);
#ifndef PROBE_REP
#define PROBE_REP 0
#endif
#define PHX(sidx, VB, VG, CALL, BAR) { const int nrep_ = 1 + ((PROBE_REP >> (sidx)) & 1); for (int rep_ = 0; rep_ < nrep_; ++rep_) { Frame F; fill_frame(F, lds, VB, VG); CALL; if (nrep_ > 1) __syncthreads(); } BAR; }
    PHX(0, bid, G, { phase_pre(F); phase_transposer(F, bid * NWAVES + F.wave, G * NWAVES, 0, split ? TR_P0 : TR_NIT); }, xcd_barrier(bar))
    if (front) {
        PHX(1, vb, NF, phase_norm1<0>(F), xcd_barrier(barf))
        PHX(2, vb, NF, phase_gemm_in(F, 0), xcd_barrier(barf))
        PHX(3, vb, NF, phase_mix_a(F, 0), xcd_barrier(barf))
        PHX(4, vb, NF, phase_hgrn_b(F), xcd_barrier(barf))
        PHX(5, vb, NF, phase_hgrn_c(F, 0), xcd_barrier(barf))
        PHX(6, vb, NF, phase_gemm_o(F, 0), xcd_barrier(barf))
        PHX(7, vb, NF, phase_norm2(F, 0), xcd_barrier(barf))
        PHX(8, vb, NF, phase_topk(F, 0), (void)0)
        { Frame F; fill_frame(F, lds, bid, G); phase_transposer_dyn(F, (unsigned*)(ws + WS_CTL) + TRQ_WORD, split ? TR_P0 : TR_NIT, TR_NIT); }
    } else {
        Frame F; fill_frame(F, lds, bid, G); phase_transposer_dyn(F, (unsigned*)(ws + WS_CTL) + TRQ_WORD, TR_P0, TR_NIT);
    }
    xcd_barrier(bar);
    PHX(9, bid, G, phase_gemm1(F, 0), xcd_barrier(bar))
    PHX(10, bid, G, phase_gemm2(F, 0), xcd_barrier(bar))
    PHX(12, bid, G, phase_norm1<1>(F), xcd_barrier(bar))
    PHX(2, bid, G, phase_gemm_in(F, 1), xcd_barrier(bar))
    PHX(3, bid, G, phase_mix_a(F, 1), xcd_barrier(bar))
    PHX(4, bid, G, phase_hgrn_b(F), xcd_barrier(bar))
    PHX(5, bid, G, phase_hgrn_c(F, 1), xcd_barrier(bar))
    PHX(13, bid, G, phase_gemm_o(F, 1), xcd_barrier(bar))
    PHX(7, bid, G, phase_norm2(F, 1), xcd_barrier(bar))
    PHX(8, bid, G, phase_topk(F, 1), xcd_barrier(bar))
    PHX(9, bid, G, phase_gemm1(F, 1), xcd_barrier(bar))
    PHX(10, bid, G, phase_gemm2(F, 1), xcd_barrier(bar))
    PHX(11, bid, G, phase_norm1<2>(F), (void)0)
#undef PHX
}
}

extern "C" void kernel_launch(void* const* d_in, const int* in_sizes, int n_in, void* d_out, int out_size, void* d_ws, size_t ws_size, hipStream_t stream) {
    static int grid = 0;
    if (grid == 0) {
        if (n_in != 19 || in_sizes[0] != NLAT * D || out_size != NLAT * D || ws_size < WS_END) {
            fprintf(stderr, "kernel_launch: unexpected shapes: n_in %d in0 %d out %d ws %zu (need %zu)\n", n_in, n_in > 0 ? in_sizes[0] : -1, out_size, ws_size, (size_t)WS_END); grid = -1; return; }
        int dev = 0, cus = 0, per_cu = 0;
        if (hipGetDevice(&dev) != hipSuccess || hipDeviceGetAttribute(&cus, hipDeviceAttributeMultiprocessorCount, dev) != hipSuccess) { grid = -1; return; }
        if (hipFuncSetAttribute((const void*)mk_fwd, hipFuncAttributeMaxDynamicSharedMemorySize, LDS_BYTES) != hipSuccess) { fprintf(stderr, "kernel_launch: hipFuncSetAttribute failed\n"); grid = -1; return; }
        if (hipOccupancyMaxActiveBlocksPerMultiprocessor(&per_cu, (const void*)mk_fwd, NTHREADS, LDS_BYTES) != hipSuccess || per_cu < 1) { fprintf(stderr, "kernel_launch: occupancy query says %d\n", per_cu); per_cu = 1; }
        (void)hipGetLastError();
        grid = cus;
    }
    if (grid < 0) return;
    (void)hipMemsetAsync((char*)d_ws + WS_CTL, 0, CTL_BYTES, stream);
    Args a{};
    for (int i = 0; i < 19; ++i) a.in[i] = (const float*)d_in[i];
    a.out = (float*)d_out; a.ws = (unsigned char*)d_ws;
    a.ph_lo = 0; a.ph_hi = NPHASES;
    void* params[] = {&a};
    hipError_t le = hipLaunchCooperativeKernel((const void*)mk_fwd, dim3(grid), dim3(NTHREADS), params, LDS_BYTES, stream);
    if (le != hipSuccess) fprintf(stderr, "kernel_launch: cooperative launch failed: %s\n", hipGetErrorName(le));
}
```

```cpp
#include <hip/hip_runtime.h>
#include <cstdio>
#include <cstdint>

#ifndef MK_ONE_LAUNCH
#define MK_ONE_LAUNCH 1
#endif

typedef unsigned short bf16_t;
typedef short bf16x8 __attribute__((ext_vector_type(8)));
typedef float f32x4 __attribute__((ext_vector_type(4)));
typedef unsigned u32x4_t __attribute__((ext_vector_type(4)));
typedef unsigned u32x2_t __attribute__((ext_vector_type(2)));
#define LAS __attribute__((address_space(3)))
#define GAS __attribute__((address_space(1)))

namespace {
constexpr int D = 1024, NB = 4, T = 4096, L = 256, NLAT = NB * T, NCTX = NB * L, NROWS = NLAT + NCTX;
constexpr int INC = 2816;
constexpr int OFF_K = 0, OFF_V = 128, OFF_I = 256, OFF_FF = 512, OFF_FB = 768, OFF_Q = 1024, OFF_HQ = 1536, OFF_G = 1792, OFF_CB = 2048, OFF_CC = 2304, OFF_CH = 2560;
constexpr int NE = 16, DE = 2048, CAP_L = 512, CAP_C = 32, EROWS = 2304;
constexpr int NSC = 68;
constexpr int NMODV = 6 * D;
constexpr int NTHREADS = 512, NWAVES = 8;
constexpr int LDS_BYTES = 144 * 1024;
constexpr int NPHASES = 22;
constexpr int TR_NIT = 2 * 16 * (2 * 16 * 32 + 32 * 16);
#ifndef TR_P0
#define TR_P0 4096
#endif

constexpr size_t al(size_t x) { return (x + 4095) & ~(size_t)4095; }
constexpr size_t WS_CTL = 0;                                   constexpr size_t CTL_BYTES = 65536;
constexpr size_t WS_MOD = WS_CTL + CTL_BYTES;
constexpr size_t WS_COS = al(WS_MOD + (size_t)2 * 5 * NMODV * 4);
constexpr size_t WS_SIN = al(WS_COS + (size_t)T * 32 * 4);
constexpr size_t WS_AFF = al(WS_SIN + (size_t)T * 32 * 4);
constexpr size_t WS_SLOT = al(WS_AFF + (size_t)NROWS * 16 * 4);
constexpr size_t WS_ROWMAP = al(WS_SLOT + (size_t)NROWS * 16 * 4);
constexpr size_t WS_GATEV = al(WS_ROWMAP + (size_t)NE * EROWS * 4);
constexpr size_t WS_HD = al(WS_GATEV + (size_t)NE * EROWS * 4);
constexpr size_t WS_HU = al(WS_HD + (size_t)NB * 2 * NSC * 4 * 64 * 4);
constexpr size_t WS_SB = al(WS_HU + (size_t)NB * 2 * NSC * 4 * 4096 * 4);
constexpr size_t WS_OF = al(WS_SB + (size_t)NB * 2 * NSC * 4 * 4096 * 4);
constexpr size_t WS_X = al(WS_OF + (size_t)NROWS * 256 * 4);
constexpr size_t WS_HN = al(WS_X + (size_t)NROWS * D * 4);
constexpr size_t WS_PL = al(WS_HN + (size_t)NROWS * D * 2);
constexpr size_t WS_MIXIN = al(WS_PL + (size_t)NROWS * INC * 2);
constexpr size_t WS_HID = al(WS_MIXIN + (size_t)NROWS * D * 2);
constexpr size_t WS_Y = al(WS_HID + (size_t)NE * EROWS * DE * 2);
constexpr size_t WS_WIN = al(WS_Y + (size_t)NE * EROWS * D * 2);
constexpr size_t WS_WO = al(WS_WIN + (size_t)2 * INC * D * 2);
constexpr size_t WS_WGU = al(WS_WO + (size_t)2 * D * D * 2);
constexpr size_t WS_WD = al(WS_WGU + (size_t)2 * NE * 2 * DE * D * 2);
constexpr size_t WS_VTL = al(WS_WD + (size_t)2 * NE * D * DE * 2);
constexpr size_t WS_VTC = al(WS_VTL + (size_t)NB * 128 * T * 2);
constexpr size_t WS_MODP = al(WS_VTC + (size_t)NB * 128 * L * 2);
constexpr size_t WS_LBT = al(WS_MODP + (size_t)4 * 2 * 5 * NMODV * 4);
constexpr size_t WS_END = al(WS_LBT + (size_t)2 * 2 * 256 * 4);

struct Args { const float* in[19]; float* out; unsigned char* ws; int ph_lo, ph_hi; };

struct Frame {
    unsigned char* lds;
    int tid, lane, wave, bid, G;
    const float *x, *c, *ctx, *c_ctx, *ada_w, *ada_b, *norm1_g, *norm2_g, *w_in, *attn_sink, *hgrn_lb, *hgrn_norm_g, *conv_w, *w_o, *router_w, *wg, *wu, *wd, *final_g;
    float* out;
    float *LBT, *MODP, *MOD, *COS, *SIN, *AFF, *GATEV, *HD, *OF, *X;
    bf16_t *HU, *SB;
    int *SLOT, *ROWMAP;
    bf16_t *HN, *PL, *MIXIN, *HID, *Y, *WIN, *WO, *WGU, *WD, *XS, *VTL, *VTC;
};

__device__ __forceinline__ float bf2f(bf16_t b) { return __uint_as_float((unsigned)b << 16); }
__device__ __forceinline__ bf16_t f2bf(float f) { unsigned u = __float_as_uint(f); u += 0x7fffu + ((u >> 16) & 1u); return (bf16_t)(u >> 16); }
__device__ __forceinline__ int wave_sum_i(int v) {
    v += __builtin_amdgcn_update_dpp(0, v, 0xB1, 0xf, 0xf, true);
    v += __builtin_amdgcn_update_dpp(0, v, 0x4E, 0xf, 0xf, true);
    v += __builtin_amdgcn_update_dpp(0, v, 0x141, 0xf, 0xf, true);
    v += __builtin_amdgcn_update_dpp(0, v, 0x140, 0xf, 0xf, true);
    v += __builtin_amdgcn_ds_swizzle(v, 0x401f);
    const auto r = __builtin_amdgcn_permlane32_swap((unsigned)v, (unsigned)v, false, false);
    return (int)r[0] + (int)r[1];
}
typedef float f32x2_t __attribute__((ext_vector_type(2)));
typedef __bf16 bf16x2_t __attribute__((ext_vector_type(2)));
__device__ __forceinline__ unsigned cvtpk(float lo, float hi) { f32x2_t v = {lo, hi}; bf16x2_t b = __builtin_convertvector(v, bf16x2_t); return __builtin_bit_cast(unsigned, b); }
__device__ __forceinline__ bf16_t f2bfq(float x) { return (bf16_t)cvtpk(x, x); }
__device__ __forceinline__ unsigned pk2(float lo, float hi) { return cvtpk(lo, hi); }
__device__ __forceinline__ float wave_sum(float v) {
    v += __int_as_float(__builtin_amdgcn_update_dpp(0, __float_as_int(v), 0xB1, 0xf, 0xf, true));
    v += __int_as_float(__builtin_amdgcn_update_dpp(0, __float_as_int(v), 0x4E, 0xf, 0xf, true));
    v += __int_as_float(__builtin_amdgcn_update_dpp(0, __float_as_int(v), 0x141, 0xf, 0xf, true));
    v += __int_as_float(__builtin_amdgcn_update_dpp(0, __float_as_int(v), 0x140, 0xf, 0xf, true));
    v += __int_as_float(__builtin_amdgcn_ds_swizzle(__float_as_int(v), 0x401f));
    const auto r = __builtin_amdgcn_permlane32_swap(__float_as_uint(v), __float_as_uint(v), false, false);
    return __uint_as_float(r[0]) + __uint_as_float(r[1]);
}
__device__ __forceinline__ float sigmoidf_(float x) { return __builtin_amdgcn_rcpf(1.f + __expf(-x)); }
__device__ __forceinline__ float siluf_(float x) { return x * __builtin_amdgcn_rcpf(1.f + __expf(-x)); }
__device__ __forceinline__ void wave_lds_sync() { asm volatile("s_waitcnt lgkmcnt(0)" ::: "memory"); }
__device__ __forceinline__ int modb(int r) { return r < NLAT ? (r >> 12) : 4; }
__device__ __forceinline__ int row_of_pos(int b, int pos) { return pos < L ? NLAT + b * L + pos : b * T + (pos - L); }
__device__ __forceinline__ float lb_val(const Frame& F, int l, int dir, int c) {
    if (l == 0) return 0.f;
    const float a0 = F.hgrn_lb[(0 * 2 + dir) * 256 + c], a1 = F.hgrn_lb[(1 * 2 + dir) * 256 + c];
    return 1.f / (1.f + __expf(a0 - a1));
}

typedef short s16x4 __attribute__((ext_vector_type(4)));
typedef short v4i16_t __attribute__((ext_vector_type(4)));
__device__ __forceinline__ s16x4 lds_tr(LAS unsigned char* p) { return __builtin_bit_cast(s16x4, __builtin_amdgcn_ds_read_tr16_b64_v4i16((LAS v4i16_t*)p)); }
template <class RM>
__device__ __forceinline__ void transpose_item(const float* __restrict__ W, int K, int N, bf16_t* __restrict__ WT, RM rowmap, LAS unsigned char* scr, int item, int lane) {
    const int nblk = N / 64, kb = item / nblk, nb = item % nblk, k0 = 64 * kb, n0 = 64 * nb;
    const int r4 = lane >> 4, q4 = lane & 15;
    const float* src = W + (size_t)(k0 + r4) * N + n0 + q4 * 4;
    f32x4 v[16];
#pragma unroll
    for (int i = 0; i < 16; ++i) v[i] = *(const f32x4*)(src + (size_t)(4 * i) * N);
    wave_lds_sync();
#pragma unroll
    for (int i = 0; i < 16; ++i) *(LAS u32x2_t*)(scr + (4 * i + r4) * 144 + q4 * 8) = (u32x2_t){cvtpk(v[i].x, v[i].y), cvtpk(v[i].z, v[i].w)};
    wave_lds_sync();
    const int trb = (8 * r4 + (q4 >> 2)) * 144 + 8 * (q4 & 3);
#pragma unroll
    for (int c16 = 0; c16 < 4; ++c16) {
        bf16_t* dst = WT + (size_t)rowmap(n0 + 16 * c16 + q4) * K + k0 + 8 * r4;
#pragma unroll
        for (int kh = 0; kh < 2; ++kh) {
            const s16x4 lo = lds_tr(scr + trb + kh * 32 * 144 + c16 * 32), hi = lds_tr(scr + trb + (kh * 32 + 4) * 144 + c16 * 32);
            *(bf16x8*)(dst + 32 * kh) = (bf16x8){lo[0], lo[1], lo[2], lo[3], hi[0], hi[1], hi[2], hi[3]};
        }
    }
}
struct RMId { __device__ __forceinline__ int operator()(int n) const { return n; } };
struct RMIn { __device__ __forceinline__ int operator()(int n) const { const int c = n & 31; return (n < 128 || (n >= OFF_Q && n < OFF_HQ)) ? n : (n & ~31) + 16 * ((c >> 2) & 1) + 4 * (c >> 3) + (c & 3); } };
struct RMGate { __device__ __forceinline__ int operator()(int n) const { return (n >> 7) * 256 + (n & 127); } };
struct RMUp { __device__ __forceinline__ int operator()(int n) const { return (n >> 7) * 256 + 128 + (n & 127); } };

__device__ __forceinline__ void phase_pre(const Frame& F) {
    float* s_l = (float*)F.lds;
    float* red = s_l + 5 * 1024;
    for (int i = F.tid; i < 5 * 1024; i += NTHREADS) { const int b = i >> 10, k = i & 1023; const float c = b < 4 ? F.c[b * 1024 + k] : F.c_ctx[k]; s_l[i] = c / (1.f + __expf(-c)); }
    __syncthreads();
    for (int item = F.bid; item < 768; item += F.G) {
        const int kq4 = item & 3, ng = item >> 2, l = ng / 96, n0 = (ng % 96) * 64, kq = F.tid >> 6, n = F.tid & 63;
        float acc[5] = {0.f, 0.f, 0.f, 0.f, 0.f};
        const int kb = kq4 * 256 + kq * 32;
        const float* W = F.ada_w + (size_t)l * D * NMODV + (size_t)kb * NMODV + n0 + n;
#pragma unroll 8
        for (int kk = 0; kk < 32; ++kk) { const float w = W[(size_t)kk * NMODV];
#pragma unroll
            for (int b = 0; b < 5; ++b) acc[b] += s_l[b * 1024 + kb + kk] * w; }
#pragma unroll
        for (int b = 0; b < 5; ++b) red[(kq * 5 + b) * 64 + n] = acc[b];
        __syncthreads();
        if (F.tid < 320) { const int b = F.tid >> 6; float s = 0.f;
#pragma unroll
            for (int q = 0; q < 8; ++q) s += red[(q * 5 + b) * 64 + n];
            if (kq4 == 0) s += F.ada_b[l * NMODV + n0 + n];
            F.MODP[(size_t)kq4 * (2 * 5 * NMODV) + (size_t)(l * 5 + b) * NMODV + n0 + n] = s; }
        __syncthreads();
    }
    for (int i = F.bid * NTHREADS + F.tid; i < 2 * 2 * 256; i += F.G * NTHREADS) { const int ll = i >> 9, dc = i & 511; F.LBT[i] = lb_val(F, ll, dc >> 8, dc & 255); }
    for (int i = F.bid * NTHREADS + F.tid; i < T * 32; i += F.G * NTHREADS) {
        const int t = i >> 5, a = (i >> 4) & 1, f = i & 15; const float pos = (float)(a == 0 ? (t >> 6) : (t & 63));
        const float inv = __builtin_amdgcn_exp2f(-(float)f * (13.287712379549449f / 16.f)); const float ang = pos * inv;
        F.COS[i] = __cosf(ang); F.SIN[i] = __sinf(ang);
    }
    LAS unsigned char* scr = (LAS unsigned char*)F.lds + F.wave * (64 * 144);
    __syncthreads();
    constexpr int I_IN = 16 * 44, I_O = 16 * 16;
    const int gw = F.bid * NWAVES + F.wave, NGW = F.G * NWAVES;
    for (int it = gw; it < 2 * (I_IN + I_O); it += NGW) {
        const int l = it / (I_IN + I_O); const int r = it % (I_IN + I_O);
        if (r < I_IN) transpose_item(F.w_in + (size_t)l * D * INC, D, INC, F.WIN + (size_t)l * INC * D, RMIn(), scr, r, F.lane);
        else transpose_item(F.w_o + (size_t)l * D * D, D, D, F.WO + (size_t)l * D * D, RMId(), scr, r - I_IN, F.lane);
    }
}
struct TrDesc { const float* src; bf16_t* WT; int K, N, kind, k0, n0; };
__device__ __forceinline__ TrDesc tr_decode(const Frame& F, int it, int lane) {
    constexpr int I_G = 16 * 32, I_D = 32 * 16, PER_E = 2 * I_G + I_D;
    TrDesc d; const size_t le = (size_t)(it / PER_E); int r = it % PER_E; const float* W;
    if (r < I_G) { W = F.wg + le * D * DE; d.WT = F.WGU + le * 2 * DE * D; d.K = D; d.N = DE; d.kind = 1; }
    else if (r < 2 * I_G) { r -= I_G; W = F.wu + le * D * DE; d.WT = F.WGU + le * 2 * DE * D; d.K = D; d.N = DE; d.kind = 2; }
    else { r -= 2 * I_G; W = F.wd + le * DE * D; d.WT = F.WD + le * D * DE; d.K = DE; d.N = D; d.kind = 0; }
    const int nblk = d.N / 64; d.k0 = 64 * (r / nblk); d.n0 = 64 * (r % nblk);
    d.src = W + (size_t)(d.k0 + (lane >> 4)) * d.N + d.n0 + (lane & 15) * 4;
    return d;
}
#define TR_LOAD(DSC, V) do { _Pragma("unroll") for (int i_ = 0; i_ < 16; ++i_) V[i_] = *(const f32x4*)((DSC).src + (size_t)(4 * i_) * (DSC).N); } while (0)
__device__ __forceinline__ void tr_store(const TrDesc& d, const f32x4 (&v)[16], LAS unsigned char* scr, int lane) {
    const int r4 = lane >> 4, q4 = lane & 15;
    wave_lds_sync();
#pragma unroll
    for (int i = 0; i < 16; ++i) *(LAS u32x2_t*)(scr + (4 * i + r4) * 144 + q4 * 8) = (u32x2_t){cvtpk(v[i].x, v[i].y), cvtpk(v[i].z, v[i].w)};
    wave_lds_sync();
    const int trb = (8 * r4 + (q4 >> 2)) * 144 + 8 * (q4 & 3);
#pragma unroll
    for (int c16 = 0; c16 < 4; ++c16) {
        const int n0_ = d.n0 + 16 * c16 + q4; const int c_ = n0_ & 31; const int n = (n0_ & ~31) + 16 * ((c_ >> 2) & 1) + 4 * (c_ >> 3) + (c_ & 3);
        const int row = d.kind == 0 ? n : (n >> 7) * 256 + (d.kind == 2 ? 128 : 0) + (n & 127);
        bf16_t* dst = d.WT + (size_t)row * d.K + d.k0 + 8 * r4;
#pragma unroll
        for (int kh = 0; kh < 2; ++kh) {
            const s16x4 lo = lds_tr(scr + trb + kh * 32 * 144 + c16 * 32), hi = lds_tr(scr + trb + (kh * 32 + 4) * 144 + c16 * 32);
            *(bf16x8*)(dst + 32 * kh) = (bf16x8){lo[0], lo[1], lo[2], lo[3], hi[0], hi[1], hi[2], hi[3]};
        }
    }
}
__device__ __forceinline__ void phase_transposer(const Frame& F, int widx, int nw, int first, int last) {
    LAS unsigned char* scr = (LAS unsigned char*)F.lds + F.wave * (64 * 144);
    const int NIT = last;
    f32x4 va[16], vb[16];
    int it = first + widx;
    if (it >= NIT) return;
    TrDesc da = tr_decode(F, it, F.lane), db = da;
    TR_LOAD(da, va);
    for (;;) {
        const bool hb = it + nw < NIT;
        if (hb) { db = tr_decode(F, it + nw, F.lane); TR_LOAD(db, vb); }
        tr_store(da, va, scr, F.lane);
        if (!hb) break;
        it += nw;
        const bool ha = it + nw < NIT;
        if (ha) { da = tr_decode(F, it + nw, F.lane); TR_LOAD(da, va); }
        tr_store(db, vb, scr, F.lane);
        if (!ha) break;
        it += nw;
    }
}
#undef TR_LOAD

template <int MODE>
__device__ __forceinline__ void phase_norm1(const Frame& F) {
    const int gw = F.bid * NWAVES + F.wave, NGW = F.G * NWAVES, lane = F.lane;
    const int nrows = MODE == 2 ? NLAT : NROWS;
    const int lprev = MODE == 1 ? 0 : 1;
    const int lcur = MODE == 0 ? 0 : 1;
    if (MODE == 0) {
        for (int i = F.bid * NTHREADS + F.tid; i < 2 * 5 * NMODV / 4; i += F.G * NTHREADS) {
            const f32x4* p = (const f32x4*)F.MODP + i; constexpr int Q = 2 * 5 * NMODV / 4;
            ((f32x4*)F.MOD)[i] = ((p[0] + p[Q]) + p[2 * Q]) + p[3 * Q];
        }
    }
    for (int r = gw; r < nrows; r += NGW) {
        const int mb = modb(r);
        f32x4 v[4];
        const float* src = MODE == 0 ? (r < NLAT ? F.x + (size_t)r * D : F.ctx + (size_t)(r - NLAT) * D) : F.X + (size_t)r * D;
#pragma unroll
        for (int j = 0; j < 4; ++j) v[j] = *(const f32x4*)(src + lane * 4 + 256 * j);
        if (MODE != 0) {
            f32x4 acc[4];
#pragma unroll
            for (int j = 0; j < 4; ++j) acc[j] = (f32x4){0.f, 0.f, 0.f, 0.f};
            int sl = -1; float gl = 0.f;
            if (lane < NE) { sl = F.SLOT[(size_t)r * 16 + lane]; if (sl >= 0) gl = F.GATEV[lane * EROWS + sl]; }
            unsigned mk = (unsigned)__ballot(sl >= 0);
            if (MODE == 1 && r >= NLAT) {
                const bf16_t* YPb = (const bf16_t*)F.OF;
                while (mk) {
                    const int e0 = __builtin_ctz(mk); mk &= mk - 1u;
                    const int s0 = __builtin_amdgcn_readlane(sl, e0); const float g0 = __int_as_float(__builtin_amdgcn_readlane(__float_as_int(gl), e0));
                    const bf16_t* y0 = YPb + ((size_t)e0 * 128 + (s0 - 4 * CAP_L)) * D; constexpr size_t QS = (size_t)NE * 128 * D;
                    uint2 w0[4], w1[4], w2[4], w3[4];
#pragma unroll
                    for (int j = 0; j < 4; ++j) { w0[j] = *(const uint2*)(y0 + lane * 4 + 256 * j); w1[j] = *(const uint2*)(y0 + QS + lane * 4 + 256 * j); w2[j] = *(const uint2*)(y0 + 2 * QS + lane * 4 + 256 * j); w3[j] = *(const uint2*)(y0 + 3 * QS + lane * 4 + 256 * j); }
#pragma unroll
                    for (int j = 0; j < 4; ++j) {
                        acc[j].x += g0 * (((__uint_as_float(w0[j].x << 16) + __uint_as_float(w1[j].x << 16)) + __uint_as_float(w2[j].x << 16)) + __uint_as_float(w3[j].x << 16));
                        acc[j].y += g0 * (((__uint_as_float(w0[j].x & 0xffff0000u) + __uint_as_float(w1[j].x & 0xffff0000u)) + __uint_as_float(w2[j].x & 0xffff0000u)) + __uint_as_float(w3[j].x & 0xffff0000u));
                        acc[j].z += g0 * (((__uint_as_float(w0[j].y << 16) + __uint_as_float(w1[j].y << 16)) + __uint_as_float(w2[j].y << 16)) + __uint_as_float(w3[j].y << 16));
                        acc[j].w += g0 * (((__uint_as_float(w0[j].y & 0xffff0000u) + __uint_as_float(w1[j].y & 0xffff0000u)) + __uint_as_float(w2[j].y & 0xffff0000u)) + __uint_as_float(w3[j].y & 0xffff0000u));
                    }
                }
            }
            while (mk) {
                const int e0 = __builtin_ctz(mk); mk &= mk - 1u;
                const bool two = mk != 0u; const int e1 = two ? __builtin_ctz(mk) : e0; if (two) mk &= mk - 1u;
                const int s0 = __builtin_amdgcn_readlane(sl, e0), s1 = __builtin_amdgcn_readlane(sl, e1);
                const float g0 = __int_as_float(__builtin_amdgcn_readlane(__float_as_int(gl), e0)), g1 = two ? __int_as_float(__builtin_amdgcn_readlane(__float_as_int(gl), e1)) : 0.f;
                const bf16_t* y0 = F.Y + ((size_t)e0 * EROWS + s0) * D; const bf16_t* y1 = F.Y + ((size_t)e1 * EROWS + s1) * D;
                uint2 w0[4], w1[4];
#pragma unroll
                for (int j = 0; j < 4; ++j) { w0[j] = *(const uint2*)(y0 + lane * 4 + 256 * j); w1[j] = *(const uint2*)(y1 + lane * 4 + 256 * j); }
#pragma unroll
                for (int j = 0; j < 4; ++j) {
                    acc[j].x += g0 * __uint_as_float(w0[j].x << 16); acc[j].y += g0 * __uint_as_float(w0[j].x & 0xffff0000u);
                    acc[j].z += g0 * __uint_as_float(w0[j].y << 16); acc[j].w += g0 * __uint_as_float(w0[j].y & 0xffff0000u);
                    acc[j].x += g1 * __uint_as_float(w1[j].x << 16); acc[j].y += g1 * __uint_as_float(w1[j].x & 0xffff0000u);
                    acc[j].z += g1 * __uint_as_float(w1[j].y << 16); acc[j].w += g1 * __uint_as_float(w1[j].y & 0xffff0000u);
                }
            }
            const float* g2 = F.MOD + (size_t)(lprev * 5 + mb) * NMODV + 5 * D;
#pragma unroll
            for (int j = 0; j < 4; ++j) { const f32x4 gg = *(const f32x4*)(g2 + lane * 4 + 256 * j); v[j] += gg * acc[j]; }
        }
        if (MODE == 1) {
#pragma unroll
            for (int j = 0; j < 4; ++j) *(f32x4*)(F.X + (size_t)r * D + lane * 4 + 256 * j) = v[j];
        }
        float ss = 0.f;
#pragma unroll
        for (int j = 0; j < 4; ++j) ss += (v[j].x * v[j].x + v[j].y * v[j].y) + (v[j].z * v[j].z + v[j].w * v[j].w);
        ss = wave_sum(ss);
        const float rstd = rsqrtf(ss * (1.f / D) + 1e-6f);
        if (MODE == 2) {
#pragma unroll
            for (int j = 0; j < 4; ++j) { const f32x4 g = *(const f32x4*)(F.final_g + lane * 4 + 256 * j); *(f32x4*)(F.out + (size_t)r * D + lane * 4 + 256 * j) = v[j] * rstd * g; }
        } else {
            const float* mv = F.MOD + (size_t)(lcur * 5 + mb) * NMODV;
#pragma unroll
            for (int j = 0; j < 4; ++j) {
                const int c0 = lane * 4 + 256 * j;
                const f32x4 g = *(const f32x4*)(F.norm1_g + lcur * D + c0);
                f32x4 sh, sc;
                if (MODE == 0) { const float* pp = F.MODP + (size_t)mb * NMODV + c0; constexpr int Q = 2 * 5 * NMODV;
                    sh = ((*(const f32x4*)pp + *(const f32x4*)(pp + Q)) + *(const f32x4*)(pp + 2 * Q)) + *(const f32x4*)(pp + 3 * Q);
                    sc = ((*(const f32x4*)(pp + D) + *(const f32x4*)(pp + D + Q)) + *(const f32x4*)(pp + D + 2 * Q)) + *(const f32x4*)(pp + D + 3 * Q); }
                else { sh = *(const f32x4*)(mv + c0); sc = *(const f32x4*)(mv + D + c0); }
                const f32x4 h = v[j] * rstd * g * (sc + 1.f) + sh;
                uint2 w; w.x = pk2(h.x, h.y); w.y = pk2(h.z, h.w);
                *(uint2*)(F.HN + (size_t)r * D + c0) = w;
            }
        }
    }
}

namespace pg8 {
typedef unsigned u32x4 __attribute__((ext_vector_type(4)));
constexpr int BM = 256, BK = 64, HALF = 128, HTB = HALF * BK * 2, STAGE_BYTES = 8 * HTB, NXCD = 8;
__device__ __forceinline__ int lds_byte(int r, int c) { const int st = (r >> 4) * 2 + (c >> 5), rr = r & 15, cc = c & 31, ob = rr * 64 + cc * 2; return st * 1024 + (ob ^ (((ob >> 9) & 1) << 5)); }
__device__ __forceinline__ void stage_rc(int b, int& R, int& C) { const int st = b / 1024, sb = b % 1024, swz = sb ^ (((sb >> 9) & 1) << 5); R = (st >> 1) * 16 + swz / 64; C = (st & 1) * 32 + (swz % 64) / 2; }
struct Unit { const char* a; const char* b; int pm, pn, e, half, nt; };
struct TileOrder {
    int nM, nN, nwg, G, c, WGM;
    __device__ __forceinline__ void init(int nM_, int nN_, int WGM_, int G_, int c_) { nM = nM_; nN = nN_; nwg = nM * nN; G = G_; c = c_; WGM = WGM_; }
    __device__ __forceinline__ bool decode(int i, int& pm, int& pn) const {
        const long Lx = (long)i * G + c; if (Lx >= nwg) return false;
        int wgid = (int)Lx; { const int q = nwg / NXCD, r = nwg % NXCD, xcd = wgid % NXCD, off = wgid / NXCD; wgid = (xcd < r ? xcd * (q + 1) : r * (q + 1) + (xcd - r) * q) + off; }
        const int nig = WGM * nN, gid = wgid / nig, fm = gid * WGM, gsz = (nM - fm) < WGM ? (nM - fm) : WGM;
        pm = fm + ((wgid % nig) % gsz); pn = (wgid % nig) / gsz; return true;
    }
};
template <class Epi, class Sched, bool ALIGN_EPI>
__device__ __forceinline__ void gemm_phase(LAS unsigned char* lds, const int tid, const int K, const Sched& S, const Epi& E) {
    const int wid = __builtin_amdgcn_readfirstlane(tid >> 6), lane = tid & 63, wr = wid >> 2, wc = wid & 3, fr = lane & 15, fq = lane >> 4;
    unsigned voffA[2];
#pragma unroll
    for (int i = 0; i < 2; ++i) { int R, C; stage_rc(tid * 16 + i * 8192, R, C); voffA[i] = (unsigned)(R * K + C) * 2u; }
    const size_t kstep = (size_t)(BK * 2);
    const size_t hstep = (size_t)HALF * K * 2;
    const unsigned ldsw = (unsigned)wid * 1024u;
    const int aoff = lds_byte(wr * 64 + fr, fq * 8), boff = lds_byte(wc * 32 + fr, fq * 8);
#define PG8_SA(b, h) (((b) * 2 + (h)) * HTB)
#define PG8_SB(b, h) ((4 + (b) * 2 + (h)) * HTB)
#define PG8_STAGE(bufoff, gbase) do { _Pragma("unroll") for (int _i = 0; _i < 2; ++_i) \
        __builtin_amdgcn_global_load_lds((const unsigned*)((const char*)(gbase) + voffA[_i]), (LAS unsigned*)(lds + (bufoff) + ldsw + _i * 8192), 16, 0, 0); } while (0)
#define PG8_LDA(dst, b, h) do { _Pragma("unroll") for (int m = 0; m < 4; ++m) _Pragma("unroll") for (int k = 0; k < 2; ++k) dst[m][k] = *(const LAS bf16x8*)(lds + PG8_SA(b, h) + aoff + m * 2048 + k * 1024); } while (0)
#define PG8_LDB(dst, b, h) do { _Pragma("unroll") for (int n = 0; n < 2; ++n) _Pragma("unroll") for (int k = 0; k < 2; ++k) dst[n][k] = *(const LAS bf16x8*)(lds + PG8_SB(b, h) + boff + n * 2048 + k * 1024); } while (0)
#define PG8_MMA(ai, bj, At, Bt) do { __builtin_amdgcn_s_setprio(1); _Pragma("unroll") for (int m = 0; m < 4; ++m) _Pragma("unroll") for (int n = 0; n < 2; ++n) _Pragma("unroll") for (int k = 0; k < 2; ++k) \
        acc[ai][bj][m][n] = __builtin_amdgcn_mfma_f32_16x16x32_bf16(Bt[n][k], At[m][k], acc[ai][bj][m][n], 0, 0, 0); __builtin_amdgcn_s_setprio(0); } while (0)
#define PG8_WAIT_V(n) asm volatile("s_waitcnt vmcnt(" #n ")" ::: "memory")
#define PG8_WAIT_L(n) asm volatile("s_waitcnt lgkmcnt(" #n ")" ::: "memory")
#define PG8_BAR __builtin_amdgcn_s_barrier()
#define PG8_SCHED __builtin_amdgcn_sched_barrier(0)
    Unit cur, nxt; int ui = 0;
    if (!S.next(0, cur)) return;
    f32x4 acc[2][2][4][2];
#pragma unroll
    for (int a = 0; a < 2; ++a)
#pragma unroll
        for (int b = 0; b < 2; ++b)
#pragma unroll
            for (int m = 0; m < 4; ++m)
#pragma unroll
                for (int n = 0; n < 2; ++n) acc[a][b][m][n] = (f32x4){0.f, 0.f, 0.f, 0.f};
    bf16x8 At[4][2], B0[2][2], B1[2][2];
    const char* cA = cur.a; const char* cB = cur.b;
    PG8_STAGE(PG8_SB(0, 0), cB); PG8_STAGE(PG8_SB(0, 1), cB + hstep); PG8_STAGE(PG8_SA(0, 0), cA); PG8_STAGE(PG8_SA(0, 1), cA + hstep);
    PG8_STAGE(PG8_SB(1, 0), cB + kstep); PG8_STAGE(PG8_SA(1, 0), cA + kstep); PG8_STAGE(PG8_SB(1, 1), cB + hstep + kstep); PG8_STAGE(PG8_SA(1, 1), cA + hstep + kstep);
    PG8_WAIT_V(0); PG8_BAR;
    if (wr == 1) PG8_BAR;
    for (;;) {
        const bool has_next = S.next(ui + 1, nxt);
        const char* nA = has_next ? nxt.a : cA; const char* nB = has_next ? nxt.b : cB;
        const int nt = cur.nt;
        for (int t = 0; t < nt; t += 2) {
            const bool last = (t == nt - 2);
            const char* a1 = cA + (size_t)(t + 1) * kstep;
            const char* a2 = last ? nA : cA + (size_t)(t + 2) * kstep; const char* b2 = last ? nB : cB + (size_t)(t + 2) * kstep;
            const char* a3 = a2 + kstep; const char* b3 = b2 + kstep;
            PG8_LDB(B0, 0, 0); PG8_LDB(B1, 0, 1); PG8_SCHED; PG8_LDA(At, 0, 0); if (t != 0) { PG8_STAGE(PG8_SA(1, 1), a1 + hstep);
            PG8_WAIT_V(8); } PG8_WAIT_L(0); PG8_BAR; PG8_MMA(0, 0, At, B0); PG8_MMA(0, 1, At, B1); PG8_BAR; PG8_SCHED;
            PG8_LDA(At, 0, 1); PG8_STAGE(PG8_SB(0, 0), b2); PG8_STAGE(PG8_SB(0, 1), b2 + hstep); PG8_STAGE(PG8_SA(0, 0), a2);
            if (t != 0) PG8_WAIT_V(8); PG8_WAIT_L(0); PG8_BAR; if (!cur.half) { PG8_MMA(1, 0, At, B0); PG8_MMA(1, 1, At, B1); } PG8_BAR; PG8_SCHED;
            PG8_LDB(B0, 1, 0); PG8_LDB(B1, 1, 1); PG8_SCHED; PG8_LDA(At, 1, 0); PG8_STAGE(PG8_SA(0, 1), a2 + hstep);
            if (t != 0) PG8_WAIT_V(8); PG8_WAIT_L(0); PG8_BAR; PG8_MMA(0, 0, At, B0); PG8_MMA(0, 1, At, B1); PG8_BAR; PG8_SCHED;
            PG8_LDA(At, 1, 1); PG8_STAGE(PG8_SB(1, 0), b3); PG8_STAGE(PG8_SB(1, 1), b3 + hstep); PG8_STAGE(PG8_SA(1, 0), a3);
            PG8_WAIT_V(8); PG8_WAIT_L(0); PG8_BAR; if (!cur.half) { PG8_MMA(1, 0, At, B0); PG8_MMA(1, 1, At, B1); } PG8_BAR; PG8_SCHED;
        }
        if constexpr (ALIGN_EPI) { if (wr == 0) PG8_BAR; }
        PG8_STAGE(PG8_SA(1, 1), nA + kstep + hstep);
        E.pre(acc, cur, wr, wc, fr, fq);
        PG8_WAIT_V(0);
        E.st(acc, cur, wr, wc, fr, fq);
        if (!has_next) break;
#pragma unroll
        for (int a = 0; a < 2; ++a)
#pragma unroll
            for (int b = 0; b < 2; ++b)
#pragma unroll
                for (int m = 0; m < 4; ++m)
#pragma unroll
                    for (int n = 0; n < 2; ++n) acc[a][b][m][n] = (f32x4){0.f, 0.f, 0.f, 0.f};
        cur = nxt; cA = nA; cB = nB; ++ui;
        if constexpr (ALIGN_EPI) { if (wr == 1) PG8_BAR; }
    }
    PG8_WAIT_V(0);
    if constexpr (!ALIGN_EPI) { if (wr == 0) PG8_BAR; }
    PG8_BAR;
#undef PG8_SA
#undef PG8_SB
#undef PG8_STAGE
#undef PG8_LDA
#undef PG8_LDB
#undef PG8_MMA
#undef PG8_WAIT_V
#undef PG8_WAIT_L
#undef PG8_BAR
#undef PG8_SCHED
}
}

typedef f32x4 acc_t[2][2][4][2];
__device__ __forceinline__ uint2 pk4(const f32x4 v) { uint2 w; w.x = pk2(v.x, v.y); w.y = pk2(v.z, v.w); return w; }

struct SchedIn { pg8::TileOrder o; const char* A; const char* B;
    __device__ __forceinline__ bool next(int i, pg8::Unit& u) const { int pm, pn; if (!o.decode(i, pm, pn)) return false; u.pm = pm; u.pn = pn; u.e = 0; u.half = 0; u.nt = D / 64; u.a = A + (size_t)pm * 256 * D * 2; u.b = B + (size_t)pn * 256 * D * 2; return true; } };
struct EpiPL { bf16_t* PL; const float* COS; const float* SIN; bf16_t* VTL; bf16_t* VTC; const float* LBTl;
    __device__ __forceinline__ void pre(acc_t& acc, const pg8::Unit& u, int wr, int wc, int fr, int fq) const {}
    __device__ __forceinline__ void st(const acc_t& acc, const pg8::Unit& u, int wr, int wc, int fr, int fq) const {
        const bool qcols = (u.pn == 4 || u.pn == 5), anyid = qcols || u.pn == 0;
#pragma unroll
        for (int ai = 0; ai < 2; ++ai)
#pragma unroll
            for (int m = 0; m < 4; ++m) {
                const int row = u.pm * 256 + ai * 128 + wr * 64 + m * 16 + fr; const bool lat = row < NLAT; const int t = row & (T - 1);
                f32x4 cs = (f32x4){1.f, 1.f, 1.f, 1.f}, sn = (f32x4){0.f, 0.f, 0.f, 0.f};
                if (anyid && lat) { cs = *(const f32x4*)(COS + t * 32 + (wc & 1) * 16 + 4 * fq); sn = *(const f32x4*)(SIN + t * 32 + (wc & 1) * 16 + 4 * fq); }
#pragma unroll
                for (int bj = 0; bj < 2; ++bj) {
                    const bool ident = qcols || (u.pn == 0 && bj == 0);
                    f32x4 x1 = acc[ai][bj][m][0], x2 = acc[ai][bj][m][1];
                    bf16_t* pb = PL + (size_t)row * INC + u.pn * 256 + bj * 128 + wc * 32;
                    if (ident) {
                        if (lat) { const f32x4 y1 = x1 * cs - x2 * sn, y2 = x2 * cs + x1 * sn; x1 = y1; x2 = y2; }
                        const uint2 w1 = pk4(x1), w2 = pk4(x2);
                        *(u32x4_t*)(pb + 8 * fq) = (u32x4_t){w1.x, w1.y, w2.x, w2.y};
                    } else {
                        if (u.pn == 2 || u.pn == 3) {
                            const float* lbp = LBTl + (u.pn - 2) * 256 + bj * 128 + wc * 32 + 8 * fq; const f32x4 l1 = *(const f32x4*)lbp, l2 = *(const f32x4*)(lbp + 4);
#pragma unroll
                            for (int i = 0; i < 4; ++i) { x1[i] = fmaxf(__logf(1.f - (1.f - l1[i]) * sigmoidf_(-x1[i])), -69.f); x2[i] = fmaxf(__logf(1.f - (1.f - l2[i]) * sigmoidf_(-x2[i])), -69.f); }
                        }
                        if (u.pn == 6 || u.pn == 7) {
#pragma unroll
                            for (int i = 0; i < 4; ++i) { x1[i] = siluf_(x1[i]); x2[i] = siluf_(x2[i]); }
                        }
                        const uint2 w1 = pk4(x1), w2 = pk4(x2);
                        *(u32x4_t*)(pb + 8 * fq) = (u32x4_t){w1.x, w1.y, w2.x, w2.y};
                    }
                }
            }
    } };
__device__ __forceinline__ void phase_gemm_in(const Frame& F, int l) {
    SchedIn S; S.o.init(NROWS / 256, INC / 256, 8, F.G, F.bid); S.A = (const char*)F.HN; S.B = (const char*)(F.WIN + (size_t)l * INC * D);
    EpiPL E{F.PL, F.COS, F.SIN, F.VTL, F.VTC, F.LBT + l * 512};
    pg8::gemm_phase<EpiPL, SchedIn, true>((LAS unsigned char*)F.lds, F.tid, D, S, E);
}
struct EpiO { float* X; const float* MODg; const float* xin; const float* cin;
    __device__ __forceinline__ void pre(acc_t& acc, const pg8::Unit& u, int wr, int wc, int fr, int fq) const {}
    __device__ __forceinline__ void st(const acc_t& acc, const pg8::Unit& u, int wr, int wc, int fr, int fq) const {
#pragma unroll
        for (int ai = 0; ai < 2; ++ai)
#pragma unroll
            for (int m = 0; m < 4; ++m) {
                const int row = u.pm * 256 + ai * 128 + wr * 64 + m * 16 + fr; const float* gp = MODg + (size_t)modb(row) * NMODV;
                const float* bp = xin ? (row < NLAT ? xin + (size_t)row * D : cin + (size_t)(row - NLAT) * D) : X + (size_t)row * D;
#pragma unroll
                for (int bj = 0; bj < 2; ++bj)
#pragma unroll
                    for (int n = 0; n < 2; ++n) { const int col = u.pn * 256 + bj * 128 + wc * 32 + 16 * n + 4 * fq; const f32x4 g = *(const f32x4*)(gp + col); *(f32x4*)(X + (size_t)row * D + col) = *(const f32x4*)(bp + col) + g * acc[ai][bj][m][n]; }
            }
    } };
__device__ __forceinline__ void phase_gemm_o(const Frame& F, int l) {
    SchedIn S; S.o.init((l == 0 ? NROWS : NLAT) / 256, D / 256, 8, F.G, F.bid); S.A = (const char*)F.MIXIN; S.B = (const char*)(F.WO + (size_t)l * D * D);
    EpiO E{F.X, F.MOD + (size_t)l * 5 * NMODV + 2 * D, l == 0 ? F.x : nullptr, F.ctx};
    pg8::gemm_phase<EpiO, SchedIn, true>((LAS unsigned char*)F.lds, F.tid, D, S, E);
}
struct SchedG { pg8::TileOrder o; const char* A; const char* B; int RT, nt; size_t a_estride, b_estride, tbytes;
    __device__ __forceinline__ bool next(int i, pg8::Unit& u) const { int pm, pn; if (!o.decode(i, pm, pn)) return false; const int e = pm / RT, rt = pm - e * RT; u.pm = rt; u.pn = pn; u.e = e; u.half = (rt == 8) ? 1 : 0; u.nt = nt;
        u.a = A + (size_t)e * a_estride + (size_t)rt * tbytes; u.b = B + (size_t)e * b_estride + (size_t)pn * tbytes; return true; } };
struct EpiHid { bf16_t* HID;
    __device__ __forceinline__ void pre(acc_t& acc, const pg8::Unit& u, int wr, int wc, int fr, int fq) const {
#pragma unroll
        for (int ai = 0; ai < 2; ++ai) if (ai == 0 || !u.half)
#pragma unroll
            for (int m = 0; m < 4; ++m)
#pragma unroll
                for (int n = 0; n < 2; ++n) { const f32x4 g = acc[ai][0][m][n], uu = acc[ai][1][m][n]; f32x4 h; h.x = siluf_(g.x) * uu.x; h.y = siluf_(g.y) * uu.y; h.z = siluf_(g.z) * uu.z; h.w = siluf_(g.w) * uu.w;
                    const uint2 w = pk4(h); acc[ai][0][m][n].x = __uint_as_float(w.x); acc[ai][0][m][n].y = __uint_as_float(w.y); }
    }
    __device__ __forceinline__ void st(const acc_t& acc, const pg8::Unit& u, int wr, int wc, int fr, int fq) const {
#pragma unroll
        for (int ai = 0; ai < 2; ++ai) if (ai == 0 || !u.half)
#pragma unroll
            for (int m = 0; m < 4; ++m) {
                const int row = u.pm * 256 + ai * 128 + wr * 64 + m * 16 + fr; bf16_t* p = HID + ((size_t)u.e * EROWS + row) * DE + u.pn * 128 + wc * 32 + 8 * fq;
                *(u32x4_t*)p = (u32x4_t){__float_as_uint(acc[ai][0][m][0].x), __float_as_uint(acc[ai][0][m][0].y), __float_as_uint(acc[ai][0][m][1].x), __float_as_uint(acc[ai][0][m][1].y)};
            }
    } };
__device__ __forceinline__ void phase_gemm1(const Frame& F, int l) {
    const int RT = l == 0 ? 9 : 8;
    SchedG S; S.o.init(NE * RT, 2 * DE / 256, RT, F.G, F.bid); S.A = (const char*)F.XS; S.B = (const char*)(F.WGU + (size_t)l * NE * 2 * DE * D); S.RT = RT;
    S.a_estride = (size_t)EROWS * D * 2; S.b_estride = (size_t)2 * DE * D * 2; S.tbytes = (size_t)256 * D * 2; S.nt = D / 64;
    EpiHid E{F.HID};
    pg8::gemm_phase<EpiHid, SchedG, true>((LAS unsigned char*)F.lds, F.tid, D, S, E);
}
struct EpiY { bf16_t* Y; bf16_t* YP;
    __device__ __forceinline__ void pre(acc_t& acc, const pg8::Unit& u, int wr, int wc, int fr, int fq) const {
#pragma unroll
        for (int ai = 0; ai < 2; ++ai) if (ai == 0 || !u.half)
#pragma unroll
            for (int m = 0; m < 4; ++m)
#pragma unroll
                for (int bj = 0; bj < 2; ++bj)
#pragma unroll
                    for (int n = 0; n < 2; ++n) { const uint2 w = pk4(acc[ai][bj][m][n]); acc[ai][bj][m][n].x = __uint_as_float(w.x); acc[ai][bj][m][n].y = __uint_as_float(w.y); }
    }
    __device__ __forceinline__ void st(const acc_t& acc, const pg8::Unit& u, int wr, int wc, int fr, int fq) const {
        asm volatile("" : "+v"(fr), "+v"(fq));
        bf16_t* base = (u.half >= 2 ? YP + (size_t)((u.half - 2) * NE + u.e) * 128 * D : Y + ((size_t)u.e * EROWS + u.pm * 256) * D) + u.pn * 256 + wc * 32 + 8 * fq;
#pragma unroll
        for (int ai = 0; ai < 2; ++ai) if (ai == 0 || !u.half)
#pragma unroll
            for (int m = 0; m < 4; ++m) {
                bf16_t* p = base + (size_t)(ai * 128 + wr * 64 + m * 16 + fr) * D;
#pragma unroll
                for (int bj = 0; bj < 2; ++bj)
                    *(u32x4_t*)(p + bj * 128) = (u32x4_t){__float_as_uint(acc[ai][bj][m][0].x), __float_as_uint(acc[ai][bj][m][0].y), __float_as_uint(acc[ai][bj][m][1].x), __float_as_uint(acc[ai][bj][m][1].y)};
            }
    } };
struct SchedG2 { pg8::TileOrder o; const char* A; const char* B; size_t a_estride, b_estride, tbytes;
    __device__ __forceinline__ bool next(int i, pg8::Unit& u) const { int pm, pn;
        if (o.decode(i, pm, pn)) { const int e = pm >> 3, rt = pm & 7; u.pm = rt; u.pn = pn; u.e = e; u.half = 0; u.nt = DE / 64;
            u.a = A + (size_t)e * a_estride + (size_t)rt * tbytes; u.b = B + (size_t)e * b_estride + (size_t)pn * tbytes; return true; }
        const long Lx = (long)i * o.G + o.c - o.nwg; if (Lx >= NE * 16) return false;
        const int L = (int)Lx, e = L >> 4, kq = L & 3; pn = (L >> 2) & 3; u.pm = 8; u.pn = pn; u.e = e; u.half = 2 + kq; u.nt = DE / 64 / 4;
        u.a = A + (size_t)e * a_estride + (size_t)8 * tbytes + (size_t)kq * (DE / 4) * 2; u.b = B + (size_t)e * b_estride + (size_t)pn * tbytes + (size_t)kq * (DE / 4) * 2; return true; } };
__device__ __forceinline__ void phase_gemm2(const Frame& F, int l) {
    EpiY E{F.Y, (bf16_t*)F.OF};
    if (l == 0) {
        SchedG2 S; S.o.init(NE * 8, D / 256, 8, F.G, F.bid); S.A = (const char*)F.HID; S.B = (const char*)F.WD;
        S.a_estride = (size_t)EROWS * DE * 2; S.b_estride = (size_t)D * DE * 2; S.tbytes = (size_t)256 * DE * 2;
        pg8::gemm_phase<EpiY, SchedG2, true>((LAS unsigned char*)F.lds, F.tid, DE, S, E);
    } else {
        SchedG S; S.o.init(NE * 8, D / 256, 8, F.G, F.bid); S.A = (const char*)F.HID; S.B = (const char*)(F.WD + (size_t)l * NE * D * DE); S.RT = 8; S.nt = DE / 64;
        S.a_estride = (size_t)EROWS * DE * 2; S.b_estride = (size_t)D * DE * 2; S.tbytes = (size_t)256 * DE * 2;
        pg8::gemm_phase<EpiY, SchedG, true>((LAS unsigned char*)F.lds, F.tid, DE, S, E);
    }
}

typedef float f32x16 __attribute__((ext_vector_type(16)));
__device__ __forceinline__ bf16x8 mk8(s16x4 lo, s16x4 hi) { return (bf16x8){lo[0], lo[1], lo[2], lo[3], hi[0], hi[1], hi[2], hi[3]}; }
constexpr int ATT_KROW = 72, ATT_TILE = 2 * 32 * ATT_KROW, ATT_BUF = 2 * ATT_TILE;
__device__ __forceinline__ void attn_unit(const Frame& F, int l, int unit) {
    const int tid = F.tid, wave = F.wave, lane = F.lane;
    const bool cq = unit >= 512;
    int b, kv, qb;
    if (!cq) { qb = unit & 63; kv = (unit >> 6) & 1; b = unit >> 7; } else { const int u = unit - 512; qb = u & 3; kv = (u >> 2) & 1; b = u >> 3; }
    const int g = wave >> 1, head = kv * 4 + g, ql = lane & 31, h = lane >> 5;
    const int q0 = qb * 64, tq0 = q0 + (wave & 1) * 32;
    const int qrow = (cq ? NLAT + b * L : b * T) + tq0 + ql;
    bf16x8 qf[4];
#pragma unroll
    for (int ks = 0; ks < 4; ++ks) qf[ks] = *(const bf16x8*)(F.PL + (size_t)qrow * INC + OFF_Q + head * 64 + 16 * ks + 8 * h);
    int jb0 = 0, jb1 = 0;
    if (!cq) { jb0 = (q0 >> 5) - 4; if (jb0 < 0) jb0 = 0; jb1 = (q0 >> 5) + 6; if (jb1 > T / 32) jb1 = T / 32; }
    const int nlb = jb1 - jb0, ntb = nlb + L / 32, npair = ntb >> 1;
    LAS bf16_t* lbuf = (LAS bf16_t*)(LAS unsigned char*)F.lds;
    const bool isk = tid < 256; const int sr = (tid & 255) >> 3, sc = tid & 7;
    const int sdst = (isk ? 0 : 32 * ATT_KROW) + sr * ATT_KROW + sc * 8;
    u32x4_t stg0, stg1;
#define ATT_GLOAD1(tt, REG) do { const bool isl_ = (tt) < nlb; const int jt_ = isl_ ? jb0 + (tt) : (tt) - nlb; \
        const bf16_t* src_ = F.PL + (size_t)((isl_ ? b * T : NLAT + b * L) + jt_ * 32 + sr) * INC + (isk ? OFF_K : OFF_V) + kv * 64 + sc * 8; \
        REG = *(const u32x4_t*)src_; } while (0)
#define ATT_LWRITE1(off, REG) do { LAS bf16_t* d_ = lbuf + (off) + sdst; *(LAS u32x2_t*)d_ = (u32x2_t){REG.x, REG.y}; *(LAS u32x2_t*)(d_ + 4) = (u32x2_t){REG.z, REG.w}; } while (0)
    const float C2 = 0.125f * 1.4426950408889634f;
    float m = -1e30f, lsum = 0.f;
    f32x16 o0, o1;
#pragma unroll
    for (int r = 0; r < 16; ++r) { o0[r] = 0.f; o1[r] = 0.f; }
    ATT_GLOAD1(0, stg0); ATT_GLOAD1(1, stg1); ATT_LWRITE1(0, stg0); ATT_LWRITE1(ATT_TILE, stg1);
    __syncthreads();
    for (int pi = 0; pi < npair; ++pi) {
        if (pi + 1 < npair) { ATT_GLOAD1(2 * pi + 2, stg0); ATT_GLOAD1(2 * pi + 3, stg1); }
        LAS bf16_t* bufp = lbuf + (pi & 1) * ATT_BUF;
        f32x16 S[2];
        {
            bf16x8 kf[2][4];
#pragma unroll
            for (int tp = 0; tp < 2; ++tp)
#pragma unroll
                for (int ks = 0; ks < 4; ++ks) kf[tp][ks] = *(const LAS bf16x8*)(bufp + tp * ATT_TILE + ql * ATT_KROW + 16 * ks + 8 * h);
#pragma unroll
            for (int r = 0; r < 16; ++r) { S[0][r] = 0.f; S[1][r] = 0.f; }
#pragma unroll
            for (int ks = 0; ks < 4; ++ks) {
                S[0] = __builtin_amdgcn_mfma_f32_32x32x16_bf16(kf[0][ks], qf[ks], S[0], 0, 0, 0);
                S[1] = __builtin_amdgcn_mfma_f32_32x32x16_bf16(kf[1][ks], qf[ks], S[1], 0, 0, 0);
            }
        }
        float mt = -1e30f;
#pragma unroll
        for (int tp = 0; tp < 2; ++tp) {
            const int ti = 2 * pi + tp; const bool isl = ti < nlb; const int dj = (jb0 + ti) * 32 - tq0;
            const bool edge = isl && (dj <= -128 || dj >= 128);
            if (edge) {
#pragma unroll
                for (int r = 0; r < 16; ++r) { const int dd = dj + (r & 3) + 8 * (r >> 2) + 4 * h - ql; if (dd > 128 || dd < -128) S[tp][r] = -1e30f; }
            }
#pragma unroll
            for (int r = 0; r < 16; ++r) mt = fmaxf(mt, S[tp][r]);
        }
        { const auto rr = __builtin_amdgcn_permlane32_swap(__float_as_uint(mt), __float_as_uint(mt), false, false); mt = fmaxf(__uint_as_float(rr[0]), __uint_as_float(rr[1])); }
        const float mts = mt * C2;
        if (!__all(mts <= m + 8.f)) {
            const float mn = fmaxf(m, mts);
            const float alpha = __builtin_amdgcn_exp2f(m - mn);
            m = mn; lsum *= alpha;
#pragma unroll
            for (int r = 0; r < 16; ++r) { o0[r] *= alpha; o1[r] *= alpha; }
        }
        float ps = 0.f;
        const float negm = -m;
#pragma unroll
        for (int tp = 0; tp < 2; ++tp)
#pragma unroll
            for (int r = 0; r < 16; ++r) { S[tp][r] = __builtin_amdgcn_exp2f(__builtin_fmaf(S[tp][r], C2, negm)); ps += S[tp][r]; }
        lsum += ps;
#pragma unroll
        for (int tp = 0; tp < 2; ++tp) {
            LAS unsigned char* vb = (LAS unsigned char*)(bufp + tp * ATT_TILE + 32 * ATT_KROW) + (4 * h + ((lane & 15) >> 2)) * (ATT_KROW * 2) + (16 * ((lane >> 4) & 1) + 4 * (lane & 3)) * 2;
#pragma unroll
            for (int sx = 0; sx < 2; ++sx) {
                const uint4 wv = make_uint4(cvtpk(S[tp][8 * sx + 0], S[tp][8 * sx + 1]), cvtpk(S[tp][8 * sx + 2], S[tp][8 * sx + 3]), cvtpk(S[tp][8 * sx + 4], S[tp][8 * sx + 5]), cvtpk(S[tp][8 * sx + 6], S[tp][8 * sx + 7]));
                const bf16x8 pb = __builtin_bit_cast(bf16x8, wv);
                LAS unsigned char* v0 = vb + (16 * sx) * (ATT_KROW * 2);
                o0 = __builtin_amdgcn_mfma_f32_32x32x16_bf16(mk8(lds_tr(v0), lds_tr(v0 + 8 * ATT_KROW * 2)), pb, o0, 0, 0, 0);
                o1 = __builtin_amdgcn_mfma_f32_32x32x16_bf16(mk8(lds_tr(v0 + 64), lds_tr(v0 + 8 * ATT_KROW * 2 + 64)), pb, o1, 0, 0, 0);
            }
        }
        if (pi + 1 < npair) { ATT_LWRITE1(((pi + 1) & 1) * ATT_BUF, stg0); ATT_LWRITE1(((pi + 1) & 1) * ATT_BUF + ATT_TILE, stg1); }
        __syncthreads();
    }
#undef ATT_GLOAD1
#undef ATT_LWRITE1
    { const auto rr = __builtin_amdgcn_permlane32_swap(__float_as_uint(lsum), __float_as_uint(lsum), false, false); lsum = __uint_as_float(rr[0]) + __uint_as_float(rr[1]); }
    const float sk = F.attn_sink[l * 8 + head] * 1.4426950408889634f;
    const float mf = fmaxf(m, sk);
    const float alpha = __builtin_amdgcn_exp2f(m - mf);
    lsum = lsum * alpha + __builtin_amdgcn_exp2f(sk - mf);
    const float sc2 = alpha / lsum;
    bf16_t* op = F.MIXIN + (size_t)qrow * D + head * 64 + 4 * h;
#pragma unroll
    for (int r4 = 0; r4 < 4; ++r4) {
        uint2 w; w.x = cvtpk(o0[4 * r4] * sc2, o0[4 * r4 + 1] * sc2); w.y = cvtpk(o0[4 * r4 + 2] * sc2, o0[4 * r4 + 3] * sc2); *(uint2*)(op + 8 * r4) = w;
        uint2 w2; w2.x = cvtpk(o1[4 * r4] * sc2, o1[4 * r4 + 1] * sc2); w2.y = cvtpk(o1[4 * r4 + 2] * sc2, o1[4 * r4 + 3] * sc2); *(uint2*)(op + 32 + 8 * r4) = w2;
    }
}

__device__ __forceinline__ int hg_row(int b, int j, int dir, int tau) { const int pos = 64 * j + (dir ? 63 - tau : tau); return row_of_pos(b, pos); }


__device__ __forceinline__ bf16x8 mk8z(s16x4 lo) { return (bf16x8){lo[0], lo[1], lo[2], lo[3], 0, 0, 0, 0}; }
__device__ __forceinline__ void hgrn_a_item(const Frame& F, int l, int item, int lane, int w) {
    const int dir = item & 1, h = (item >> 1) & 3, j = (item >> 3) % NSC, b = item / (8 * NSC);
    const int i16 = lane & 15, q = lane >> 4;
    LAS unsigned char* wl = (LAS unsigned char*)F.lds + w * 16384;
    LAS bf16_t* KD = (LAS bf16_t*)wl; LAS bf16_t* Vv = (LAS bf16_t*)(wl + 8192);
    const int zoff = (dir ? OFF_FB : OFF_FF) + h * 64 + lane;
    float suffix = 0.f;
    bf16_t zr[64];
#pragma unroll
    for (int t = 0; t < 64; ++t) zr[t] = (F.PL + (size_t)hg_row(b, j, dir, t) * INC)[zoff];
    wave_lds_sync();
#pragma unroll
    for (int t = 63; t >= 0; --t) {
        const float lf = bf2f(zr[t]);
        KD[t * 64 + lane] = f2bfq((1.f - __expf(lf)) * __expf(suffix));
        suffix += lf;
    }
    const size_t base = (size_t)(((b * 2 + dir) * NSC + j) * 4 + h);
    F.HD[base * 64 + lane] = __expf(suffix);
#pragma unroll
    for (int i = 0; i < 8; ++i) { const int sg = (lane >> 3) + 8 * i; const int row = hg_row(b, j, dir, sg);
        const u32x4_t v = *(const u32x4_t*)(F.PL + (size_t)row * INC + OFF_I + h * 64 + (lane & 7) * 8); *(LAS u32x4_t*)(Vv + sg * 64 + (lane & 7) * 8) = v; }
    wave_lds_sync();
    f32x4 U[4][4];
#pragma unroll
    for (int dt = 0; dt < 4; ++dt)
#pragma unroll
        for (int vt = 0; vt < 4; ++vt) U[dt][vt] = (f32x4){0.f, 0.f, 0.f, 0.f};
#pragma unroll
    for (int ks = 0; ks < 2; ++ks) {
        bf16x8 af[4], bfr[4];
        const int r0 = (32 * ks + 4 * q + (i16 >> 2)) * 128 + 8 * (i16 & 3);
#pragma unroll
        for (int t4 = 0; t4 < 4; ++t4) {
            af[t4] = mk8(lds_tr((LAS unsigned char*)KD + r0 + 32 * t4), lds_tr((LAS unsigned char*)KD + r0 + 16 * 128 + 32 * t4));
            bfr[t4] = mk8(lds_tr((LAS unsigned char*)Vv + r0 + 32 * t4), lds_tr((LAS unsigned char*)Vv + r0 + 16 * 128 + 32 * t4));
        }
#pragma unroll
        for (int dt = 0; dt < 4; ++dt)
#pragma unroll
            for (int vt = 0; vt < 4; ++vt) U[dt][vt] = __builtin_amdgcn_mfma_f32_16x16x32_bf16(af[dt], bfr[vt], U[dt][vt], 0, 0, 0);
    }
    bf16_t* Uo = F.HU + base * 4096 + lane * 4;
#pragma unroll
    for (int dt = 0; dt < 4; ++dt)
#pragma unroll
        for (int vt = 0; vt < 4; ++vt) *(uint2*)(Uo + (dt * 4 + vt) * 256) = pk4(U[dt][vt]);
}

__device__ __forceinline__ void phase_hgrn_b(const Frame& F) {
    const bf16_t* __restrict__ HU = F.HU; const float* __restrict__ HD = F.HD; bf16_t* __restrict__ SB = F.SB;
    for (int idx = F.bid * NTHREADS + F.tid; idx < NB * 2 * 4 * 4096; idx += F.G * NTHREADS) {
        const int e = idx & 4095, h = (idx >> 12) & 3, dir = (idx >> 14) & 1, b = idx >> 15;
        const int d = 16 * (e >> 10) + 4 * ((e >> 6) & 3) + (e & 3);
        float S = 0.f;
        for (int p0 = 0; p0 < NSC; p0 += 17) {
            float u[17], dd[17]; size_t bs[17];
#pragma unroll
            for (int i = 0; i < 17; ++i) { const int p = p0 + i; const int j = dir ? (p < 4 ? 3 - p : 71 - p) : p; bs[i] = (size_t)(((b * 2 + dir) * NSC + j) * 4 + h); u[i] = bf2f(HU[bs[i] * 4096 + e]); dd[i] = HD[bs[i] * 64 + d]; }
#pragma unroll
            for (int i = 0; i < 17; ++i) { SB[bs[i] * 4096 + e] = f2bfq(S); S = dd[i] * S + u[i]; }
        }
    }
}

constexpr int HGC_WL = 14848;
__device__ __forceinline__ void hgrn_c_block(const Frame& F, int l, int item) {
    const int lane = F.lane, w = F.wave, h = w & 3, dir = w >> 2, j = item % NSC, b = item / NSC;
    const int i16 = lane & 15, q = lane >> 4;
    LAS unsigned char* wl = (LAS unsigned char*)F.lds + w * HGC_WL;
    LAS bf16_t* Qp = (LAS bf16_t*)wl; LAS bf16_t* Kp = (LAS bf16_t*)(wl + 2048); LAS bf16_t* Vv = (LAS bf16_t*)(wl + 4096);
    LAS float* hv = (LAS float*)(wl + 6144); LAS float* gv = (LAS float*)(wl + 6400); LAS bf16_t* Ot = (LAS bf16_t*)(wl + 6656);
    const int zoff = (dir ? OFF_FB : OFF_FF) + h * 64 + lane, qoff = OFF_HQ + h * 64 + lane;
    const size_t base = (size_t)(((b * 2 + dir) * NSC + j) * 4 + h);
    f32x4 S[4][4];
    { const bf16_t* sb = F.SB + base * 4096 + lane * 4;
#pragma unroll
    for (int dt = 0; dt < 4; ++dt)
#pragma unroll
        for (int vt = 0; vt < 4; ++vt) { const uint2 w = *(const uint2*)(sb + (dt * 4 + vt) * 256);
            S[dt][vt] = (f32x4){__uint_as_float(w.x << 16), __uint_as_float(w.x & 0xffff0000u), __uint_as_float(w.y << 16), __uint_as_float(w.y & 0xffff0000u)}; } }
    bf16_t zr[16], hr[16]; u32x4_t vr[2];
    const int vlane = OFF_I + h * 64 + (lane & 7) * 8;
#define HGC_LOAD(cc) do { _Pragma("unroll") for (int tau = 0; tau < 16; ++tau) { const bf16_t* prow = F.PL + (size_t)hg_row(b, j, dir, (cc) * 16 + tau) * INC; zr[tau] = prow[zoff]; hr[tau] = prow[qoff]; } \
        _Pragma("unroll") for (int i = 0; i < 2; ++i) { const int row = hg_row(b, j, dir, (cc) * 16 + (lane >> 3) + 8 * i); vr[i] = *(const u32x4_t*)(F.PL + (size_t)row * INC + vlane); } } while (0)
    HGC_LOAD(0);
    for (int c = 0; c < 4; ++c) {
        {
            float kk[16], lam[16], qq[16]; float run = 0.f;
#pragma unroll
            for (int tau = 0; tau < 16; ++tau) {
                const float lf = bf2f(zr[tau]);
                kk[tau] = 1.f - __expf(lf);
                run += lf; lam[tau] = run;
                qq[tau] = bf2f(hr[tau]);
            }
            const float lmid = lam[7];
            wave_lds_sync();
#pragma unroll
            for (int tau = 0; tau < 16; ++tau) { Qp[tau * 64 + lane] = f2bfq(qq[tau] * __expf(fminf(lam[tau] - lmid, 60.f))); Kp[tau * 64 + lane] = f2bfq(kk[tau] * __expf(fminf(lmid - lam[tau], 60.f))); }
            hv[lane] = __expf(lmid); gv[lane] = __expf(run - lmid);
        }
#pragma unroll
        for (int i = 0; i < 2; ++i) *(LAS u32x4_t*)(Vv + ((lane >> 3) + 8 * i) * 64 + (lane & 7) * 8) = vr[i];
        if (c < 3) HGC_LOAD(c + 1);
        wave_lds_sync();
        bf16x8 afr;
        {
            const bf16x8 ka0 = *(const LAS bf16x8*)(Kp + i16 * 64 + 8 * q), ka1 = *(const LAS bf16x8*)(Kp + i16 * 64 + 32 + 8 * q);
            const bf16x8 qb0 = *(const LAS bf16x8*)(Qp + i16 * 64 + 8 * q), qb1 = *(const LAS bf16x8*)(Qp + i16 * 64 + 32 + 8 * q);
            f32x4 At = (f32x4){0.f, 0.f, 0.f, 0.f};
            At = __builtin_amdgcn_mfma_f32_16x16x32_bf16(ka0, qb0, At, 0, 0, 0);
            At = __builtin_amdgcn_mfma_f32_16x16x32_bf16(ka1, qb1, At, 0, 0, 0);
#pragma unroll
            for (int r = 0; r < 4; ++r) if (4 * q + r > i16) At[r] = 0.f;
            const uint4 wv = make_uint4(cvtpk(At[0], At[1]), cvtpk(At[2], At[3]), 0u, 0u); afr = __builtin_bit_cast(bf16x8, wv);
        }
        const int trb = (4 * q + (i16 >> 2)) * 128 + 8 * (i16 & 3);
        bf16x8 bv[4];
#pragma unroll
        for (int vt = 0; vt < 4; ++vt) bv[vt] = mk8z(lds_tr((LAS unsigned char*)Vv + trb + 32 * vt));
#pragma unroll
        for (int dt = 0; dt < 4; ++dt) { const f32x4 hr = *(const LAS f32x4*)(hv + 16 * dt + 4 * q);
#pragma unroll
            for (int vt = 0; vt < 4; ++vt) S[dt][vt] *= hr; }
        bf16x8 aq[2];
#pragma unroll
        for (int kb = 0; kb < 2; ++kb) { const u32x2_t lo = *(const LAS u32x2_t*)(Qp + i16 * 64 + 32 * kb + 4 * q), hi = *(const LAS u32x2_t*)(Qp + i16 * 64 + 32 * kb + 16 + 4 * q);
            const uint4 wv = make_uint4(lo.x, lo.y, hi.x, hi.y); aq[kb] = __builtin_bit_cast(bf16x8, wv); }
#pragma unroll
        for (int vt = 0; vt < 4; ++vt) {
            f32x4 o = (f32x4){0.f, 0.f, 0.f, 0.f};
#pragma unroll
            for (int kb = 0; kb < 2; ++kb) {
                const f32x4 s0 = S[2 * kb][vt], s1 = S[2 * kb + 1][vt];
                const uint4 wv = make_uint4(cvtpk(s0[0], s0[1]), cvtpk(s0[2], s0[3]), cvtpk(s1[0], s1[1]), cvtpk(s1[2], s1[3]));
                o = __builtin_amdgcn_mfma_f32_16x16x32_bf16(aq[kb], __builtin_bit_cast(bf16x8, wv), o, 0, 0, 0);
            }
            o = __builtin_amdgcn_mfma_f32_16x16x32_bf16(afr, bv[vt], o, 0, 0, 0);
#pragma unroll
            for (int r = 0; r < 4; ++r) { const int t16 = c * 16 + 4 * q + r; const int tok = dir ? 63 - t16 : t16; Ot[tok * 64 + 16 * vt + i16] = f2bfq(o[r]); }
        }
#pragma unroll
        for (int dt = 0; dt < 4; ++dt) {
            const bf16x8 kt = mk8z(lds_tr((LAS unsigned char*)Kp + trb + 32 * dt));
            const f32x4 gr = *(const LAS f32x4*)(gv + 16 * dt + 4 * q);
#pragma unroll
            for (int vt = 0; vt < 4; ++vt) S[dt][vt] = __builtin_amdgcn_mfma_f32_16x16x32_bf16(kt, bv[vt], S[dt][vt], 0, 0, 0) * gr;
        }
    }
#undef HGC_LOAD
    wave_lds_sync();
    __syncthreads();
    {
        const int hh = w & 3, half = w >> 2;
        LAS bf16_t* Of = (LAS bf16_t*)((LAS unsigned char*)F.lds + hh * HGC_WL + 6656); LAS bf16_t* Ob = (LAS bf16_t*)((LAS unsigned char*)F.lds + (hh + 4) * HGC_WL + 6656);
        const float gain = F.hgrn_norm_g[l * 256 + hh * 64 + lane];
#pragma unroll 8
        for (int tk = 0; tk < 32; ++tk) {
            const int tok = half * 32 + tk; const int row = row_of_pos(b, 64 * j + tok);
            const float o = bf2f(Of[tok * 64 + lane]) + bf2f(Ob[tok * 64 + lane]);
            const float ss = wave_sum(o * o);
            const float rstd = rsqrtf(ss * (1.f / 64.f) + 1e-6f);
            const float g = bf2f(F.PL[(size_t)row * INC + OFF_G + hh * 64 + lane]);
            F.MIXIN[(size_t)row * D + 512 + hh * 64 + lane] = f2bfq(o * rstd * gain * g);
        }
    }
    __syncthreads();
}

__device__ __forceinline__ void conv_rows(const Frame& F, int l, int r0, int r1, int tid_in, int nthr) {
    for (int idx = r0 * 32 + tid_in; idx < r1 * 32; idx += nthr) {
        const int r = idx >> 5, c = (idx & 31) * 8;
        int tt, len; if (r < NLAT) { tt = r & (T - 1); len = T; } else { tt = (r - NLAT) & (L - 1); len = L; }
        const bf16_t* row = F.PL + (size_t)r * INC;
        const u32x4_t z4 = (u32x4_t){0u, 0u, 0u, 0u};
        const u32x4_t cb = *(const u32x4_t*)(row + OFF_CB + c), c1 = *(const u32x4_t*)(row + OFF_CC + c), h1 = *(const u32x4_t*)(row + OFF_CH + c);
        const u32x4_t c0 = tt > 0 ? *(const u32x4_t*)(row + OFF_CC + c - INC) : z4, h0 = tt > 0 ? *(const u32x4_t*)(row + OFF_CH + c - INC) : z4;
        const u32x4_t c2 = tt < len - 1 ? *(const u32x4_t*)(row + OFF_CC + c + INC) : z4, h2 = tt < len - 1 ? *(const u32x4_t*)(row + OFF_CH + c + INC) : z4;
        const float* wp = F.conv_w + l * 768 + c;
        u32x4_t o;
#pragma unroll
        for (int i = 0; i < 4; ++i) {
            const float w0a = wp[2 * i], w0b = wp[2 * i + 1], w1a = wp[256 + 2 * i], w1b = wp[256 + 2 * i + 1], w2a = wp[512 + 2 * i], w2b = wp[512 + 2 * i + 1];
#define LO(x) __uint_as_float((x) << 16)
#define HI(x) __uint_as_float((x) & 0xffff0000u)
            const float ua = w0a * (LO(c0[i]) * LO(h0[i])) + w1a * (LO(c1[i]) * LO(h1[i])) + w2a * (LO(c2[i]) * LO(h2[i]));
            const float ub = w0b * (HI(c0[i]) * HI(h0[i])) + w1b * (HI(c1[i]) * HI(h1[i])) + w2b * (HI(c2[i]) * HI(h2[i]));
            o[i] = cvtpk(LO(cb[i]) * ua, HI(cb[i]) * ub);
#undef LO
#undef HI
        }
        *(u32x4_t*)(F.MIXIN + (size_t)r * D + 768 + c) = o;
    }
}

#ifndef PROBE_SUB
#define PROBE_SUB 0
#endif
__device__ __forceinline__ void phase_mix_a(const Frame& F, int l) {
    const int gw = F.bid * NWAVES + F.wave, NGW = F.G * NWAVES;
    for (int rep = 0; rep < 1 + (PROBE_SUB & 1); ++rep)
    for (int it = gw; it < NB * NSC * 4 * 2; it += NGW) hgrn_a_item(F, l, it, F.lane, F.wave);
    for (int rep = 0; rep < 1 + ((PROBE_SUB >> 1) & 1); ++rep)
    {
        const int extra = NB * NSC * 4 * 2 - NGW, nb2 = extra > 0 ? (extra + NWAVES - 1) / NWAVES : 0;
        if (2 * nb2 <= F.G) { if (F.bid >= nb2) conv_rows(F, l, 0, l == 0 ? NROWS : NLAT, (F.bid - nb2) * NTHREADS + F.tid, (F.G - nb2) * NTHREADS); }
        else conv_rows(F, l, 0, l == 0 ? NROWS : NLAT, F.bid * NTHREADS + F.tid, F.G * NTHREADS);
    }
    const int nat = l == 0 ? 512 + 32 : 512;
    __syncthreads();
    for (int rep = 0; rep < 1 + ((PROBE_SUB >> 2) & 1); ++rep)
    for (int it = F.bid; it < nat; it += F.G) attn_unit(F, l, it);
}

__device__ __forceinline__ void phase_hgrn_c(const Frame& F, int l) {
    if (l == 0) { for (int it = F.bid; it < NB * NSC; it += F.G) hgrn_c_block(F, l, it); }
    else { for (int it = F.bid; it < NB * 64; it += F.G) hgrn_c_block(F, l, (it >> 6) * NSC + 4 + (it & 63)); }
}

__device__ __forceinline__ void phase_norm2(const Frame& F, int l) {
    const int gw = F.bid * NWAVES + F.wave, NGW = F.G * NWAVES, lane = F.lane;
    const int nrows = l == 0 ? NROWS : NLAT;
    const float* RW = F.router_w + (size_t)l * D * NE;
    float* rwt = (float*)F.lds;
    for (int i = F.tid; i < D * NE / 4; i += NTHREADS) { const f32x4 w = *(const f32x4*)(RW + (size_t)i * 4); const int k = i >> 2, e0 = (i & 3) * 4;
        rwt[(e0 + 0) * D + k] = w.x; rwt[(e0 + 1) * D + k] = w.y; rwt[(e0 + 2) * D + k] = w.z; rwt[(e0 + 3) * D + k] = w.w; }
    __syncthreads();
    for (int r = gw; r < nrows; r += NGW) {
        const int mb = modb(r);
        f32x4 v[4]; float ss = 0.f;
#pragma unroll
        for (int j = 0; j < 4; ++j) { v[j] = *(const f32x4*)(F.X + (size_t)r * D + lane * 4 + 256 * j); ss += (v[j].x * v[j].x + v[j].y * v[j].y) + (v[j].z * v[j].z + v[j].w * v[j].w); }
        ss = wave_sum(ss);
        const float rstd = rsqrtf(ss * (1.f / D) + 1e-6f);
        const float* mv = F.MOD + (size_t)(l * 5 + mb) * NMODV;
        float lg[16];
#pragma unroll
        for (int e = 0; e < 16; ++e) lg[e] = 0.f;
#pragma unroll
        for (int j = 0; j < 4; ++j) {
            const int c0 = lane * 4 + 256 * j;
            const f32x4 g = *(const f32x4*)(F.norm2_g + l * D + c0), sh = *(const f32x4*)(mv + 3 * D + c0), sc = *(const f32x4*)(mv + 4 * D + c0);
            const f32x4 h = v[j] * rstd * g * (sc + 1.f) + sh;
            uint2 w; w.x = pk2(h.x, h.y); w.y = pk2(h.z, h.w);
            *(uint2*)(F.HN + (size_t)r * D + c0) = w;
#pragma unroll
            for (int e = 0; e < 16; ++e) { const f32x4 w4 = *(const f32x4*)(rwt + e * D + c0); lg[e] += (h.x * w4.x + h.y * w4.y) + (h.z * w4.z + h.w * w4.w); if ((e & 7) == 7) asm volatile("" ::: "memory"); }
        }
        float mx = -1e30f;
#pragma unroll
        for (int e = 0; e < 16; ++e) { lg[e] = wave_sum(lg[e]); mx = fmaxf(mx, lg[e]); }
        float den = 0.f;
#pragma unroll
        for (int e = 0; e < 16; ++e) { lg[e] = __expf(lg[e] - mx); den += lg[e]; }
        const float inv = 1.f / den;
        float mine = 0.f;
#pragma unroll
        for (int e = 0; e < 16; ++e) if (lane == e) mine = lg[e] * inv;
        if (lane < 16) F.AFF[(size_t)lane * NROWS + r] = mine;
    }
}

__device__ __forceinline__ void topk_item(const Frame& F, int item, int nq) {
    const int nlat = 64 * nq; const bool lat = item < nlat; const int it = lat ? item / nq : item - nlat; const int q = lat ? item % nq : 0; const int b = it >> 4, e = it & 15;
    const int N = lat ? T : L, cap = lat ? CAP_L : CAP_C, rowbase = lat ? b * T : NLAT + b * L, mbase = lat ? b * CAP_L : 4 * CAP_L + b * CAP_C;
    const int share = (CAP_L + nq - 1) / nq;
    const int slo = lat ? q * share : 0, shi = lat ? (q * share + share < CAP_L ? q * share + share : CAP_L) : CAP_C;
    const int ept = lat ? 8 : 1; const int nact = N / ept; const bool act = F.tid < nact;
    unsigned* wc = (unsigned*)F.lds;
    int* sel = (int*)F.lds + 16;
    unsigned ku[8];
#pragma unroll
    for (int i = 0; i < 8; ++i) ku[i] = 0u;
    if (act) {
        const float* ap = F.AFF + (size_t)e * NROWS + rowbase + F.tid * ept;
        if (lat) { const u32x4_t a0 = *(const u32x4_t*)ap, a1 = *(const u32x4_t*)(ap + 4); ku[0] = a0.x; ku[1] = a0.y; ku[2] = a0.z; ku[3] = a0.w; ku[4] = a1.x; ku[5] = a1.y; ku[6] = a1.z; ku[7] = a1.w; }
        else ku[0] = __float_as_uint(ap[0]);
    }
    unsigned* hist = (unsigned*)F.lds + 512;
    unsigned* res = hist + 256;
    unsigned thr = 0u, pmask = 0u, need = (unsigned)cap;
    for (int pass = 0; pass < 4; ++pass) {
        const int shift = 24 - 8 * pass;
        if (F.tid < 256) hist[F.tid] = 0u;
        __syncthreads();
        if (act) {
#pragma unroll
            for (int i = 0; i < 8; ++i) if (i < ept) { if ((ku[i] & pmask) == thr) atomicAdd(&hist[(ku[i] >> shift) & 255u], 1u); }
        }
        __syncthreads();
        if (F.wave == 0) {
            const unsigned c0 = hist[4 * F.lane], c1 = hist[4 * F.lane + 1], c2 = hist[4 * F.lane + 2], c3 = hist[4 * F.lane + 3];
            const unsigned sme = (c0 + c1) + (c2 + c3);
            unsigned suf = sme;
#pragma unroll
            for (int o = 1; o < 64; o <<= 1) { const unsigned t = (unsigned)__builtin_amdgcn_ds_bpermute(((F.lane + o) & 63) << 2, (int)suf); if (F.lane + o < 64) suf += t; }
            const unsigned above = suf - sme;
            if (above < need && need <= above + sme) {
                unsigned cum = above; int bin; unsigned rem;
                if (cum + c3 >= need) { bin = 3; rem = need - cum; }
                else { cum += c3; if (cum + c2 >= need) { bin = 2; rem = need - cum; } else { cum += c2; if (cum + c1 >= need) { bin = 1; rem = need - cum; } else { cum += c1; bin = 0; rem = need - cum; } } }
                res[0] = (unsigned)(4 * F.lane + bin); res[1] = rem;
            }
        }
        __syncthreads();
        thr |= res[0] << shift; pmask |= 255u << shift; need = res[1];
    }
    const unsigned tg = (unsigned)cap - need;
    unsigned cg = 0, ce = 0;
    if (act) {
#pragma unroll
        for (int i = 0; i < 8; ++i) if (i < ept) { cg += (ku[i] > thr) ? 1u : 0u; ce += (ku[i] == thr) ? 1u : 0u; }
    }
    unsigned pk = cg | (ce << 16), inc = pk;
#pragma unroll
    for (int o = 1; o < 64; o <<= 1) { const unsigned t = (unsigned)__builtin_amdgcn_ds_bpermute(((F.lane - o) & 63) << 2, (int)inc); if (F.lane >= o) inc += t; }
    if (F.lane == 63) wc[F.wave] = inc;
    __syncthreads();
    unsigned pre = 0, total = 0;
#pragma unroll
    for (int w = 0; w < NWAVES; ++w) { const unsigned t = wc[w]; if (w < F.wave) pre += t; total += t; }
    unsigned excl = pre + inc - pk;
    unsigned pg = excl & 0xffffu, pe = excl >> 16; (void)total;
    if (act) {
#pragma unroll
        for (int i = 0; i < 8; ++i) if (i < ept) {
            const int row = rowbase + F.tid * ept + i; int slot = -1;
            if (ku[i] > thr) slot = (int)pg++;
            else if (ku[i] == thr) { if (pe < need) slot = (int)(tg + pe); ++pe; }
            if (slot >= slo && slot < shi) { sel[slot - slo] = row; F.GATEV[e * EROWS + mbase + slot] = __uint_as_float(ku[i]); }
            if (q == 0) F.SLOT[(size_t)row * 16 + e] = slot >= 0 ? mbase + slot : -1;
        }
    }
    __syncthreads();
    const int nsl = shi - slo;
    for (int s0 = F.wave * 4; s0 < nsl; s0 += NWAVES * 4) {
        u32x4_t va[4], vb[4];
#pragma unroll
        for (int i = 0; i < 4; ++i) { const int sidx = s0 + i < nsl ? s0 + i : nsl - 1; const u32x4_t* src = (const u32x4_t*)(F.HN + (size_t)sel[sidx] * D) + F.lane * 2; va[i] = src[0]; vb[i] = src[1]; }
#pragma unroll
        for (int i = 0; i < 4; ++i) if (s0 + i < nsl) { u32x4_t* dst = (u32x4_t*)(F.XS + ((size_t)e * EROWS + mbase + slo + s0 + i) * D) + F.lane * 2; dst[0] = va[i]; dst[1] = vb[i]; }
    }
    if (!lat && b == 0) {
        for (int i = F.tid; i < EROWS - (4 * CAP_L + 4 * CAP_C); i += NTHREADS) F.GATEV[e * EROWS + 4 * CAP_L + 4 * CAP_C + i] = 0.f;
        uint4* z = (uint4*)(F.XS + ((size_t)e * EROWS + 4 * CAP_L + 4 * CAP_C) * D);
        for (int i = F.tid; i < (EROWS - (4 * CAP_L + 4 * CAP_C)) * D / 8; i += NTHREADS) z[i] = make_uint4(0u, 0u, 0u, 0u);
    }
}

__device__ __forceinline__ void phase_topk(const Frame& F, int l) {
    const int nq = l == 0 ? (F.G < 256 ? 2 : 3) : 4;
    const int n = l == 0 ? 64 * nq + 64 : 64 * 4;
    for (int it = F.bid; it < n; it += F.G) { topk_item(F, it, nq); __syncthreads(); }
}

#define XB_TMO      128
#define XB_XCNT(j)  (256  + 64 * (j))
#define XB_XSUB(j)  (1280 + 64 * (j))
#define XB_XGEN(j)  (2304 + 64 * (j))
#define XB_TOP      3328
#define XB_TOPGEN   3392
#define XCD_BAR_WORDS 3456
#define XB_SPIN_CAP (1u << 20)
__device__ __forceinline__ unsigned xb_ld(unsigned* p)              { return __hip_atomic_load(p, __ATOMIC_RELAXED, __HIP_MEMORY_SCOPE_AGENT); }
__device__ __forceinline__ unsigned xb_add(unsigned* p, unsigned v) { return __hip_atomic_fetch_add(p, v, __ATOMIC_RELAXED, __HIP_MEMORY_SCOPE_AGENT); }
__device__ __forceinline__ unsigned xb_xcc_id() { return (unsigned)__builtin_amdgcn_s_getreg((3 << 11) | 20) & 0xFu; }
#define XB_SPIN(cond, bar) do { unsigned _sp = 0; while (cond) { __builtin_amdgcn_s_sleep(1); \
    if ((++_sp & 255u) == 0u) { if (xb_ld(&(bar)[XB_TMO])) break; if (_sp > XB_SPIN_CAP) { atomicAdd(&(bar)[XB_TMO], 1u); break; } } } } while (0)
struct XcdBarrier { unsigned* bar; unsigned x; volatile LAS unsigned* st; unsigned gsize; };
__device__ __forceinline__ XcdBarrier xcd_barrier_post(unsigned* bar, volatile LAS unsigned* st, unsigned gsize) {
    XcdBarrier b; b.bar = bar; b.x = xb_xcc_id(); b.st = st; b.gsize = gsize;
    if (threadIdx.x == 0) (void)xb_add(&bar[XB_XCNT(b.x)], 1u);
    return b;
}
__device__ __forceinline__ void xcd_barrier_complete(unsigned* bar, unsigned x, unsigned& nloc, unsigned& nx, const unsigned G) {
    unsigned sum, cnt, mine, sp = 0u;
    for (;;) {
        sum = 0u; cnt = 0u; mine = 0u;
#pragma nounroll
        for (unsigned j = 0; j < 16; ++j) { const unsigned c = xb_ld(&bar[XB_XCNT(j)]); sum += c; cnt += (c > 0u) ? 1u : 0u; mine = (j == x) ? c : mine; }
        if (sum == G) break;
        __builtin_amdgcn_s_sleep(1);
        if ((++sp & 255u) == 0u) { if (xb_ld(&bar[XB_TMO])) break; if (sp > XB_SPIN_CAP) { atomicAdd(&bar[XB_TMO], 1u); break; } }
    }
    nloc = mine > 0u ? mine : 1u; nx = cnt > 0u ? cnt : 1u;
}
__device__ __forceinline__ void xcd_barrier(const XcdBarrier& b) {
    asm volatile("s_waitcnt vmcnt(0)" ::: "memory");
    __syncthreads();
    if (threadIdx.x == 0) {
        unsigned* bar = b.bar;
        __builtin_amdgcn_s_waitcnt(0);
        unsigned nloc = b.st[0], nx = b.st[1];
        if (nloc == 0u) { xcd_barrier_complete(bar, b.x, nloc, nx, b.gsize); b.st[0] = nloc; b.st[1] = nx; }
        const unsigned old = xb_add(&bar[XB_XSUB(b.x)], 1u);
        const unsigned gen = old / nloc;
        if (old + 1u == (gen + 1u) * nloc) {
            __builtin_amdgcn_fence(__ATOMIC_RELEASE, "agent");
            asm volatile("s_waitcnt vmcnt(0)" ::: "memory");
            const unsigned og = xb_add(&bar[XB_TOP], 1u);
            const unsigned tg = og / nx;
            if (og + 1u == (tg + 1u) * nx) xb_add(&bar[XB_TOPGEN], 1u);
            else XB_SPIN(xb_ld(&bar[XB_TOPGEN]) == tg, bar);
            __builtin_amdgcn_fence(__ATOMIC_ACQUIRE, "agent");
            xb_add(&bar[XB_XGEN(b.x)], 1u);
            asm volatile("s_waitcnt vmcnt(0)" ::: "memory");
        } else {
            XB_SPIN(xb_ld(&bar[XB_XGEN(b.x)]) == gen, bar);
            __builtin_amdgcn_fence(__ATOMIC_ACQUIRE, "agent");
            asm volatile("s_waitcnt vmcnt(0)" ::: "memory");
        }
    }
    __syncthreads();
}

__device__ __forceinline__ void run_phase(const Frame& F, int ph) {
    if (ph == 0) { phase_pre(F); return; }
    if (ph == NPHASES - 1) { phase_norm1<2>(F); return; }
    const int l = (ph - 1) / 10, s = (ph - 1) % 10;
    switch (s) {
        case 0: if (l == 0) phase_norm1<0>(F); else phase_norm1<1>(F); break;
        case 1: phase_gemm_in(F, l); break;
        case 2: phase_mix_a(F, l); break;
        case 3: phase_hgrn_b(F); break;
        case 4: phase_hgrn_c(F, l); break;
        case 5: phase_gemm_o(F, l); break;
        case 6: phase_norm2(F, l); break;
        case 7: phase_topk(F, l); break;
        case 8: phase_gemm1(F, l); break;
        default: phase_gemm2(F, l); break;
    }
}

template <int OFF> __device__ __forceinline__ unsigned long long ldarg() {
    unsigned long long v; asm volatile("s_load_dwordx2 %0, %1, %2\n\ts_waitcnt lgkmcnt(0)" : "=s"(v) : "s"(__builtin_amdgcn_kernarg_segment_ptr()), "i"(OFF) : "memory"); return v; }
__device__ __forceinline__ void fill_frame(Frame& F, unsigned char* lds, int vbid, int vG) {
    int tid = threadIdx.x; asm volatile("" : "+v"(tid));
    int bid = __builtin_amdgcn_readfirstlane(vbid), G = __builtin_amdgcn_readfirstlane(vG); asm volatile("" : "+s"(bid), "+s"(G));
    F.lds = lds; F.tid = tid; F.lane = tid & 63; F.wave = __builtin_amdgcn_readfirstlane(tid >> 6); F.bid = bid; F.G = G;
    F.x = (const float*)(const GAS float*)ldarg<0>(); F.c = (const float*)(const GAS float*)ldarg<8>(); F.ctx = (const float*)(const GAS float*)ldarg<16>(); F.c_ctx = (const float*)(const GAS float*)ldarg<24>(); F.ada_w = (const float*)(const GAS float*)ldarg<32>(); F.ada_b = (const float*)(const GAS float*)ldarg<40>();
    F.norm1_g = (const float*)(const GAS float*)ldarg<48>(); F.norm2_g = (const float*)(const GAS float*)ldarg<56>(); F.w_in = (const float*)(const GAS float*)ldarg<64>(); F.attn_sink = (const float*)(const GAS float*)ldarg<72>(); F.hgrn_lb = (const float*)(const GAS float*)ldarg<80>();
    F.hgrn_norm_g = (const float*)(const GAS float*)ldarg<88>(); F.conv_w = (const float*)(const GAS float*)ldarg<96>(); F.w_o = (const float*)(const GAS float*)ldarg<104>(); F.router_w = (const float*)(const GAS float*)ldarg<112>(); F.wg = (const float*)(const GAS float*)ldarg<120>();
    F.wu = (const float*)(const GAS float*)ldarg<128>(); F.wd = (const float*)(const GAS float*)ldarg<136>(); F.final_g = (const float*)(const GAS float*)ldarg<144>(); F.out = (float*)(GAS float*)ldarg<152>();
    unsigned char* ws = (unsigned char*)(GAS unsigned char*)ldarg<160>();
    F.MOD = (float*)(ws + WS_MOD); F.COS = (float*)(ws + WS_COS); F.SIN = (float*)(ws + WS_SIN); F.AFF = (float*)(ws + WS_AFF); F.SLOT = (int*)(ws + WS_SLOT);
    F.ROWMAP = (int*)(ws + WS_ROWMAP); F.GATEV = (float*)(ws + WS_GATEV); F.HD = (float*)(ws + WS_HD); F.HU = (bf16_t*)(ws + WS_HU); F.SB = (bf16_t*)(ws + WS_SB);
    F.OF = (float*)(ws + WS_OF); F.X = (float*)(ws + WS_X); F.HN = (bf16_t*)(ws + WS_HN); F.PL = (bf16_t*)(ws + WS_PL); F.MIXIN = (bf16_t*)(ws + WS_MIXIN);
    F.HID = (bf16_t*)(ws + WS_HID); F.Y = (bf16_t*)(ws + WS_Y); F.WIN = (bf16_t*)(ws + WS_WIN); F.WO = (bf16_t*)(ws + WS_WO); F.WGU = (bf16_t*)(ws + WS_WGU); F.WD = (bf16_t*)(ws + WS_WD); F.XS = (bf16_t*)(ws + WS_PL); F.VTL = (bf16_t*)(ws + WS_VTL); F.VTC = (bf16_t*)(ws + WS_VTC); F.MODP = (float*)(ws + WS_MODP); F.LBT = (float*)(ws + WS_LBT);
}

__global__ void __launch_bounds__(NTHREADS, 2) mk_fwd(Args args) {
    extern __shared__ __attribute__((aligned(16))) unsigned char lds[];
    unsigned char* ws = args.ws;
    const int G = gridDim.x, bid = blockIdx.x;
#ifndef TR_GS
#define TR_GS 32
#endif
    const bool split = (G % TR_GS) == 0;
    const int grp = bid / TR_GS, idx = bid % TR_GS;
    const bool front = !split || idx < TR_GS - 8;
    const int NF = split ? (G / TR_GS) * (TR_GS - 8) : G, NT = G - NF;
    const int vb = !split ? bid : (front ? grp * (TR_GS - 8) + idx : grp * 8 + (idx - (TR_GS - 8)));
    volatile LAS unsigned* st = (volatile LAS unsigned*)(LAS unsigned char*)(lds + LDS_BYTES - 16);
    if (threadIdx.x == 0) { st[0] = 0u; st[1] = 0u; st[2] = 0u; st[3] = 0u; }
    __syncthreads();
    XcdBarrier bar = xcd_barrier_post((unsigned*)(ws + WS_CTL), st, (unsigned)G);
    XcdBarrier barf = bar;
    if (split && front) barf = xcd_barrier_post((unsigned*)(ws + WS_CTL) + XCD_BAR_WORDS, st + 2, (unsigned)NF);
#ifndef PROBE_REP
#define PROBE_REP 0
#endif
#define PHX(sidx, VB, VG, CALL, BAR) { const int nrep_ = 1 + ((PROBE_REP >> (sidx)) & 1); for (int rep_ = 0; rep_ < nrep_; ++rep_) { Frame F; fill_frame(F, lds, VB, VG); CALL; if (nrep_ > 1) __syncthreads(); } BAR; }
    PHX(0, bid, G, { phase_pre(F); phase_transposer(F, bid * NWAVES + F.wave, G * NWAVES, 0, split ? TR_P0 : TR_NIT); }, xcd_barrier(bar))
    if (front) {
        PHX(1, vb, NF, phase_norm1<0>(F), xcd_barrier(barf))
        PHX(2, vb, NF, phase_gemm_in(F, 0), xcd_barrier(barf))
        PHX(3, vb, NF, phase_mix_a(F, 0), xcd_barrier(barf))
        PHX(4, vb, NF, phase_hgrn_b(F), xcd_barrier(barf))
        PHX(5, vb, NF, phase_hgrn_c(F, 0), xcd_barrier(barf))
        PHX(6, vb, NF, phase_gemm_o(F, 0), xcd_barrier(barf))
        PHX(7, vb, NF, phase_norm2(F, 0), xcd_barrier(barf))
        PHX(8, vb, NF, phase_topk(F, 0), (void)0)
    } else {
        Frame F; fill_frame(F, lds, bid, G); phase_transposer(F, vb * NWAVES + F.wave, NT * NWAVES, TR_P0, TR_NIT);
    }
    xcd_barrier(bar);
    PHX(9, bid, G, phase_gemm1(F, 0), xcd_barrier(bar))
    PHX(10, bid, G, phase_gemm2(F, 0), xcd_barrier(bar))
    PHX(12, bid, G, phase_norm1<1>(F), xcd_barrier(bar))
    PHX(2, bid, G, phase_gemm_in(F, 1), xcd_barrier(bar))
    PHX(3, bid, G, phase_mix_a(F, 1), xcd_barrier(bar))
    PHX(4, bid, G, phase_hgrn_b(F), xcd_barrier(bar))
    PHX(5, bid, G, phase_hgrn_c(F, 1), xcd_barrier(bar))
    PHX(13, bid, G, phase_gemm_o(F, 1), xcd_barrier(bar))
    PHX(7, bid, G, phase_norm2(F, 1), xcd_barrier(bar))
    PHX(8, bid, G, phase_topk(F, 1), xcd_barrier(bar))
    PHX(9, bid, G, phase_gemm1(F, 1), xcd_barrier(bar))
    PHX(10, bid, G, phase_gemm2(F, 1), xcd_barrier(bar))
    PHX(11, bid, G, phase_norm1<2>(F), (void)0)
#undef PHX
}
}

extern "C" void kernel_launch(void* const* d_in, const int* in_sizes, int n_in, void* d_out, int out_size, void* d_ws, size_t ws_size, hipStream_t stream) {
    static int grid = 0;
    if (grid == 0) {
        if (n_in != 19 || in_sizes[0] != NLAT * D || out_size != NLAT * D || ws_size < WS_END) {
            fprintf(stderr, "kernel_launch: unexpected shapes: n_in %d in0 %d out %d ws %zu (need %zu)\n", n_in, n_in > 0 ? in_sizes[0] : -1, out_size, ws_size, (size_t)WS_END); grid = -1; return; }
        int dev = 0, cus = 0, per_cu = 0;
        if (hipGetDevice(&dev) != hipSuccess || hipDeviceGetAttribute(&cus, hipDeviceAttributeMultiprocessorCount, dev) != hipSuccess) { grid = -1; return; }
        if (hipFuncSetAttribute((const void*)mk_fwd, hipFuncAttributeMaxDynamicSharedMemorySize, LDS_BYTES) != hipSuccess) { fprintf(stderr, "kernel_launch: hipFuncSetAttribute failed\n"); grid = -1; return; }
        if (hipOccupancyMaxActiveBlocksPerMultiprocessor(&per_cu, (const void*)mk_fwd, NTHREADS, LDS_BYTES) != hipSuccess || per_cu < 1) { fprintf(stderr, "kernel_launch: occupancy query says %d\n", per_cu); per_cu = 1; }
        (void)hipGetLastError();
        grid = cus;
    }
    if (grid < 0) return;
    (void)hipMemsetAsync((char*)d_ws + WS_CTL, 0, CTL_BYTES, stream);
    Args a{};
    for (int i = 0; i < 19; ++i) a.in[i] = (const float*)d_in[i];
    a.out = (float*)d_out; a.ws = (unsigned char*)d_ws;
    a.ph_lo = 0; a.ph_hi = NPHASES;
    void* params[] = {&a};
    hipError_t le = hipLaunchCooperativeKernel((const void*)mk_fwd, dim3(grid), dim3(NTHREADS), params, LDS_BYTES, stream);
    if (le != hipSuccess) fprintf(stderr, "kernel_launch: cooperative launch failed: %s\n", hipGetErrorName(le));
}
```
